# Optimizing an MI355X kernel written in HIP

```python
import jax
import jax.numpy as jnp
from jax import lax
import numpy as np


D_MODEL = 1024
BATCH = 1
SEQ = 16384
DEPTH = 2

GRID_W = 64
CTX_LEN = 256
N_EVEN = (DEPTH + 1) // 2
N_ODD = DEPTH // 2
EPS = 1e-6
A_HEADS = 4
A_DK = 128
A_DV = 128
A_KW = A_HEADS * A_DK
A_WIDTH = A_HEADS * A_DV
CHUNK = 64
B_HEADS = 8
B_DH = 64
B_WIDTH = B_HEADS * B_DH
WIN_ROWS = 8
WIN_COLS = 16
Q_BLOCK_ROWS = 2
IN_SIZES = (A_KW, A_KW, A_KW, A_WIDTH, A_WIDTH, B_WIDTH, B_WIDTH, B_WIDTH)
IN_WIDTH = 3 * A_KW + 2 * A_WIDTH + 3 * B_WIDTH
POOL_WINDOWS = (2, 4, 8, 16)
C_GROUP = D_MODEL // 4
N_EXPERTS = 16
N_GROUPS = 4
EXPERTS_PER_GROUP = N_EXPERTS // N_GROUPS
TOP_K = 2
D_EXPERT = 512

kernel_name = 'hybrid_hgrn2_natten_pool_moe_dit'


def rms_norm(x, g):
    xf = x.astype(jnp.float32)
    y = xf * lax.rsqrt(jnp.mean(xf * xf, axis=-1, keepdims=True) + EPS)
    return (y * g.astype(jnp.float32)).astype(x.dtype)


def adaln(cond, w, b):
    return jnp.split(jax.nn.silu(cond) @ w + b, 6, axis=-1)


def modulate(u, shift, scale):
    return u * (1 + scale) + shift


def to_heads(t, h):
    b_, l_, hd = t.shape
    return t.reshape(b_, l_, h, hd // h).transpose(0, 2, 1, 3)


def hgrn_lower_bounds(lb_logits):
    p = jax.nn.softmax(lb_logits.astype(jnp.float32), axis=0)
    return jnp.cumsum(p, axis=0)[1:] - p[0]


def gated_scan(q, k, v, log_f, s0):
    b_, h_, l_, _ = q.shape
    n = l_ // CHUNK

    def to_chunks(t):
        return jnp.moveaxis(t.reshape(b_, h_, n, CHUNK, t.shape[-1]), 2, 0)

    causal = jnp.tril(jnp.ones((CHUNK, CHUNK), bool))[:, :, None]

    def step(s, inp):
        qi, ki, vi, fi = inp
        bc = jnp.cumsum(fi, axis=2)
        diff = bc[:, :, :, None, :] - bc[:, :, None, :, :]
        decay = jnp.exp(jnp.where(causal, diff, -jnp.inf))
        scores = jnp.einsum('bhtk,bhsk,bhtsk->bhts', qi, ki, decay)
        o = (jnp.einsum('bhts,bhsv->bhtv', scores, vi)
             + jnp.einsum('bhtk,bhkv->bhtv', qi * jnp.exp(bc), s))
        b_last = bc[:, :, -1:, :]
        s_new = (jnp.exp(b_last[:, :, 0, :, None]) * s
                 + jnp.einsum('bhsk,bhsv->bhkv', ki * jnp.exp(b_last - bc), vi))
        return s_new, o

    s_fin, oc = lax.scan(step, s0, (to_chunks(q), to_chunks(k), to_chunks(v), to_chunks(log_f)))
    return jnp.moveaxis(oc, 0, 2).reshape(b_, h_, l_, v.shape[-1]), s_fin


def context_final_state(k, v, log_f):
    bc = jnp.cumsum(log_f, axis=2)
    return jnp.einsum('bhsk,bhsv->bhkv', k * jnp.exp(bc[:, :, -1:, :] - bc), v)


def hgrn2_direction(q_c, i_c, f_c, q_l, i_l, f_l, lb_dir, reverse, ctx_out):
    def heads(t):
        t = to_heads(t, A_HEADS)
        return t[:, :, ::-1] if reverse else t

    def gates(f_raw):
        f = lb_dir + (1.0 - lb_dir) * jax.nn.sigmoid(f_raw.astype(jnp.float32))
        return heads(1.0 - f), heads(jnp.log(f))

    scale = A_DK ** -0.5
    k_c, lf_c = gates(f_c)
    v_c = heads(i_c.astype(jnp.float32))
    if ctx_out:
        s0 = jnp.zeros(k_c.shape[:2] + (A_DK, A_DV), jnp.float32)
        o_c, s_c = gated_scan(heads(q_c.astype(jnp.float32)) * scale, k_c, v_c, lf_c, s0)
    else:
        o_c, s_c = None, context_final_state(k_c, v_c, lf_c)
    k_l, lf_l = gates(f_l)
    o_l, _ = gated_scan(heads(q_l.astype(jnp.float32)) * scale, k_l, heads(i_l.astype(jnp.float32)), lf_l, s_c)
    if reverse:
        o_l = o_l[:, :, ::-1]
        o_c = None if o_c is None else o_c[:, :, ::-1]
    return o_c, o_l


def hgrn2_readout(o, g, norm_g):
    o = o * lax.rsqrt(jnp.mean(o * o, axis=-1, keepdims=True) + EPS)
    b_, h_, l_, v_ = o.shape
    o = o.transpose(0, 2, 1, 3).reshape(b_, l_, h_ * v_) * norm_g.astype(jnp.float32)
    return (o * jax.nn.silu(g.astype(jnp.float32))).astype(g.dtype)


def neighbourhood_attention(q, k, v, k_ctx, v_ctx, rpb):
    b_, n_, h_, dh = q.shape
    rows = n_ // GRID_W
    wr = min(WIN_ROWS, rows)
    wc = WIN_COLS
    nwin = wr * wc
    qb = Q_BLOCK_ROWS * GRID_W
    scale = dh ** -0.5
    cols = jnp.arange(GRID_W)
    key_cols = jnp.clip(cols - wc // 2, 0, GRID_W - wc)[:, None] + jnp.arange(wc)
    dc = key_cols - cols[:, None] + (WIN_COLS - 1)
    rpb = rpb.astype(jnp.float32)

    def block(blk):
        r = blk * Q_BLOCK_ROWS + jnp.arange(Q_BLOCK_ROWS)
        key_rows = jnp.clip(r - wr // 2, 0, rows - wr)[:, None] + jnp.arange(wr)
        dr = key_rows - r[:, None] + (WIN_ROWS - 1)
        idx = (key_rows[:, None, :, None] * GRID_W + key_cols[None, :, None, :]).reshape(qb, nwin)
        bias = rpb[:, dr[:, None, :, None], dc[None, :, None, :]].reshape(h_, qb, nwin)
        q_blk = lax.dynamic_slice_in_dim(q, blk * qb, qb, axis=1)
        k_win = jnp.take(k, idx, axis=1)
        v_win = jnp.take(v, idx, axis=1)
        s_win = jnp.einsum('bqhd,bqkhd->bhqk', q_blk, k_win).astype(jnp.float32) * scale + bias
        s_ctx = jnp.einsum('bqhd,bchd->bhqc', q_blk, k_ctx).astype(jnp.float32) * scale
        p = jax.nn.softmax(jnp.concatenate([s_win, s_ctx], axis=-1), axis=-1).astype(q.dtype)
        return (jnp.einsum('bhqk,bqkhd->bqhd', p[..., :nwin], v_win)
                + jnp.einsum('bhqc,bchd->bqhd', p[..., nwin:], v_ctx))

    out = lax.map(block, jnp.arange(rows // Q_BLOCK_ROWS))
    return jnp.moveaxis(out, 0, 1).reshape(b_, n_, h_ * dh)


def context_attention(q, k, v):
    s = jnp.einsum('bqhd,bkhd->bhqk', q, k).astype(jnp.float32) * (q.shape[-1] ** -0.5)
    p = jax.nn.softmax(s, axis=-1).astype(q.dtype)
    o = jnp.einsum('bhqk,bkhd->bqhd', p, v)
    return o.reshape(o.shape[0], o.shape[1], -1)


def even_mixer(u_c, u_l, w_in, w_out, lb, a_norm_g, rpb, ctx_out):
    offs = [int(o) for o in np.cumsum(IN_SIZES)[:-1]]
    qa_c, ff_c, fb_c, ia_c, ga_c, qb_c, kb_c, vb_c = jnp.split(u_c @ w_in, offs, axis=-1)
    qa_l, ff_l, fb_l, ia_l, ga_l, qb_l, kb_l, vb_l = jnp.split(u_l @ w_in, offs, axis=-1)
    o_cf, o_lf = hgrn2_direction(qa_c, ia_c, ff_c, qa_l, ia_l, ff_l, lb[0], False, ctx_out)
    o_cb, o_lb = hgrn2_direction(qa_c, ia_c, fb_c, qa_l, ia_l, fb_l, lb[1], True, ctx_out)
    a_l = hgrn2_readout(o_lf + o_lb, ga_l, a_norm_g)
    bh = lambda t: t.reshape(t.shape[0], t.shape[1], B_HEADS, B_DH)
    b_l = neighbourhood_attention(bh(qb_l), bh(kb_l), bh(vb_l), bh(kb_c), bh(vb_c), rpb)
    y_l = jnp.concatenate([a_l, b_l.astype(a_l.dtype)], axis=-1) @ w_out
    if not ctx_out:
        return None, y_l
    a_c = hgrn2_readout(o_cf + o_cb, ga_c, a_norm_g)
    b_c = context_attention(bh(qb_c), bh(kb_c), bh(vb_c))
    y_c = jnp.concatenate([a_c, b_c.astype(a_c.dtype)], axis=-1) @ w_out
    return y_c, y_l


def pool_mixer(u, w_pool, pool_scale):
    b_, l_, d_ = u.shape
    uf = u.astype(jnp.float32)
    csum = jnp.concatenate([jnp.zeros((b_, 1, d_), jnp.float32), jnp.cumsum(uf, axis=1)], axis=1)
    t = np.arange(l_)
    outs = []
    for g, win in enumerate(POOL_WINDOWS):
        ch = slice(g * C_GROUP, (g + 1) * C_GROUP)
        lo = np.clip(t - win // 2, 0, l_)
        hi = np.clip(t + win // 2, 0, l_)
        count = (hi - lo).astype(np.float32)[:, None]
        cg = csum[:, :, ch]
        mean = (cg[:, hi] - cg[:, lo]) / count
        outs.append(jnp.einsum('bld,de->ble', mean - uf[:, :, ch], w_pool[g].astype(jnp.float32)))
    return (jnp.concatenate(outs, axis=-1) * pool_scale.astype(jnp.float32)).astype(u.dtype)


def grouped_moe(u, w_router, b_router, w_gate, w_up, w_down):
    s = jax.nn.sigmoid(jnp.einsum('bld,de->ble', u, w_router).astype(jnp.float32))
    sb = s + b_router.astype(jnp.float32)
    grp = sb.reshape(sb.shape[:-1] + (N_GROUPS, EXPERTS_PER_GROUP))
    group_score = jnp.sum(lax.top_k(grp, 2)[0], axis=-1)
    sel_group = jnp.argmax(group_score, axis=-1)
    in_group = (jnp.arange(N_EXPERTS) // EXPERTS_PER_GROUP) == sel_group[..., None]
    _, idx = lax.top_k(jnp.where(in_group, sb, -jnp.inf), TOP_K)
    w_sel = jnp.take_along_axis(s, idx, axis=-1)
    w_sel = w_sel / jnp.sum(w_sel, axis=-1, keepdims=True)
    gates = jnp.sum(jax.nn.one_hot(idx, N_EXPERTS, dtype=jnp.float32) * w_sel[..., None], axis=-2).astype(u.dtype)
    y = jnp.zeros_like(u)
    for e in range(N_EXPERTS):
        h = jax.nn.silu(u @ w_gate[e]) * (u @ w_up[e])
        y = y + gates[..., e:e + 1] * (h @ w_down[e])
    return y


def setup_inputs(seed: int = 0) -> dict:
    key = jax.random.key(seed)
    ks = jax.random.split(key, 21)

    def nrm(k, shape, s):
        return jax.random.normal(k, shape, jnp.float32) * s

    return {
        'x': nrm(ks[0], (BATCH, SEQ, D_MODEL), 1.0),
        'c': nrm(ks[1], (BATCH, D_MODEL), 1.0),
        'ctx': nrm(ks[2], (BATCH, CTX_LEN, D_MODEL), 1.0),
        'c_ctx': nrm(ks[3], (D_MODEL,), 1.0),
        'w_mod': nrm(ks[4], (DEPTH, D_MODEL, 6 * D_MODEL), 0.5 * D_MODEL ** -0.5),
        'b_mod': nrm(ks[5], (DEPTH, 6 * D_MODEL), 0.02),
        'norm1_g': 1.0 + nrm(ks[6], (DEPTH, D_MODEL), 0.05),
        'norm2_g': 1.0 + nrm(ks[7], (DEPTH, D_MODEL), 0.05),
        'w_in': nrm(ks[8], (N_EVEN, D_MODEL, IN_WIDTH), D_MODEL ** -0.5),
        'w_out': nrm(ks[9], (N_EVEN, A_WIDTH + B_WIDTH, D_MODEL), (A_WIDTH + B_WIDTH) ** -0.5),
        'lb_logits': nrm(ks[10], (N_EVEN + 1, 2, A_KW), 0.5),
        'a_norm_g': 1.0 + nrm(ks[11], (N_EVEN, A_WIDTH), 0.05),
        'rpb': nrm(ks[12], (N_EVEN, B_HEADS, 2 * WIN_ROWS - 1, 2 * WIN_COLS - 1), 0.1),
        'w_pool': nrm(ks[13], (N_ODD, len(POOL_WINDOWS), C_GROUP, C_GROUP), C_GROUP ** -0.5),
        'pool_scale': 1.0 + nrm(ks[14], (N_ODD, D_MODEL), 0.1),
        'w_router': nrm(ks[15], (D_MODEL, N_EXPERTS), D_MODEL ** -0.5),
        'b_router': nrm(ks[16], (N_EXPERTS,), 0.01),
        'w_gate': nrm(ks[17], (DEPTH, N_EXPERTS, D_MODEL, D_EXPERT), D_MODEL ** -0.5),
        'w_up': nrm(ks[18], (DEPTH, N_EXPERTS, D_MODEL, D_EXPERT), D_MODEL ** -0.5),
        'w_down': nrm(ks[19], (DEPTH, N_EXPERTS, D_EXPERT, D_MODEL), D_EXPERT ** -0.5),
        'final_g': 1.0 + nrm(ks[20], (D_MODEL,), 0.05),
    }


def reference(x, c, ctx, c_ctx, w_mod, b_mod, norm1_g, norm2_g, w_in, w_out, lb_logits, a_norm_g,
              rpb, w_pool, pool_scale, w_router, b_router, w_gate, w_up, w_down, final_g):
    last_even = ((DEPTH - 1) // 2) * 2
    lbs = hgrn_lower_bounds(lb_logits)
    cond_l = c[:, None, :]
    cond_c = c_ctx[None, None, :]
    h_c, h_l = ctx, x
    for layer in range(DEPTH):
        j = layer // 2
        ctx_in = layer <= last_even
        ctx_out = layer < last_even
        sh1, sc1, g1, sh2, sc2, g2 = adaln(cond_l, w_mod[layer], b_mod[layer])
        u_l = modulate(rms_norm(h_l, norm1_g[layer]), sh1, sc1)
        if ctx_in:
            mc = adaln(cond_c, w_mod[layer], b_mod[layer])
            u_c = modulate(rms_norm(h_c, norm1_g[layer]), mc[0], mc[1])
        if layer % 2 == 0:
            y_c, y_l = even_mixer(u_c, u_l, w_in[j], w_out[j], lbs[j], a_norm_g[j], rpb[j], ctx_out)
        else:
            y_l = pool_mixer(u_l, w_pool[j], pool_scale[j])
            y_c = pool_mixer(u_c, w_pool[j], pool_scale[j]) if ctx_out else None
        h_l = h_l + g1 * y_l
        h_l = h_l + g2 * grouped_moe(modulate(rms_norm(h_l, norm2_g[layer]), sh2, sc2),
                                     w_router, b_router, w_gate[layer], w_up[layer], w_down[layer])
        if ctx_out:
            h_c = h_c + mc[2] * y_c
            h_c = h_c + mc[5] * grouped_moe(modulate(rms_norm(h_c, norm2_g[layer]), mc[3], mc[4]),
                                            w_router, b_router, w_gate[layer], w_up[layer], w_down[layer])
    return rms_norm(h_l, final_g)
```

```cpp
#include <hip/hip_runtime.h>
#include <cstdio>
#include <cstdint>

#ifndef N_LAUNCH_MODE
#define N_LAUNCH_MODE 0
#endif

typedef unsigned short bf16_t;
typedef short bf16x8 __attribute__((ext_vector_type(8)));
typedef float f32x16 __attribute__((ext_vector_type(16)));
typedef __bf16 bf16x2_t __attribute__((ext_vector_type(2)));
#define LAS __attribute__((address_space(3)))

constexpr int D = 1024, SEQ = 16384, CTXL = 256, NTOK = SEQ + CTXL, INW = 4096;
constexpr int NPH = 17;
constexpr int NTHREADS = 512;
constexpr int LDS_BYTES = 147456;
constexpr float EPS = 1e-6f;

constexpr size_t MiB = 1024 * 1024;
constexpr size_t WS_CTL = 0;
constexpr size_t CTL_BYTES = 65536;
constexpr size_t CTL_CNT_OFF = 16384;
constexpr size_t WS_MOD = 65536;
constexpr size_t WS_WIN = 1 * MiB;
constexpr size_t WS_WOUT = 9 * MiB;
constexpr size_t WS_WPOOL = 11 * MiB;
constexpr size_t WS_WG0 = 12 * MiB;
constexpr size_t WS_WU0 = 28 * MiB;
constexpr size_t WS_WD0 = 44 * MiB;
constexpr size_t WS_U = 60 * MiB;
constexpr size_t WS_PROJ = 100 * MiB;
constexpr size_t WS_WG1 = WS_PROJ;
constexpr size_t WS_WU1 = WS_PROJ + 16 * MiB;
constexpr size_t WS_WD1 = WS_PROJ + 32 * MiB;
constexpr size_t WS_HBUF = WS_PROJ + 48 * MiB;
constexpr size_t WS_HL = 230 * MiB;
constexpr size_t WS_HS = 262 * MiB;
constexpr size_t WS_HD = 294 * MiB;
constexpr size_t WS_LIST = 295 * MiB;
constexpr size_t WS_WL = 297 * MiB;
constexpr size_t WS_END = 300 * MiB;

__device__ __forceinline__ unsigned f2bf(float f) { unsigned u = __float_as_uint(f); u += 0x7fffu + ((u >> 16) & 1u); return u >> 16; }
__device__ __forceinline__ float bf2f(unsigned b) { return __uint_as_float(b << 16); }
__device__ __forceinline__ unsigned pk2(float lo, float hi) { return f2bf(lo) | (f2bf(hi) << 16); }
__device__ __forceinline__ float bflo(unsigned w) { return __uint_as_float(w << 16); }
__device__ __forceinline__ float bfhi(unsigned w) { return __uint_as_float(w & 0xffff0000u); }
__device__ __forceinline__ float wave_sum(float v) {
#pragma unroll
    for (int o = 1; o < 64; o <<= 1) v += __shfl_xor(v, o);
    return v;
}
__device__ __forceinline__ int tid_opaque() { int t = threadIdx.x; asm volatile("" : "+v"(t)); return t; }
__device__ __forceinline__ float sigmoidf_(float x) { return 1.0f / (1.0f + __expf(-x)); }
__device__ __forceinline__ float siluf_(float x) { return x / (1.0f + __expf(-x)); }
__device__ __forceinline__ float dot2bf(unsigned a, unsigned b, float acc) {
    return __builtin_amdgcn_fdot2_f32_bf16(__builtin_bit_cast(bf16x2_t, a), __builtin_bit_cast(bf16x2_t, b), acc, false);
}

#define XB_TMO      128
#define XB_XCNT(j)  (256  + 64 * (j))
#define XB_XSUB(j)  (1280 + 64 * (j))
#define XB_XGEN(j)  (2304 + 64 * (j))
#define XB_TOP      3328
#define XB_TOPGEN   3392
#define XCD_BAR_WORDS 3456
#define XB_SPIN_CAP (1u << 22)
__device__ __forceinline__ unsigned xb_ld(unsigned* p)              { return __hip_atomic_load(p, __ATOMIC_RELAXED, __HIP_MEMORY_SCOPE_AGENT); }
__device__ __forceinline__ unsigned xb_add(unsigned* p, unsigned v) { return __hip_atomic_fetch_add(p, v, __ATOMIC_RELAXED, __HIP_MEMORY_SCOPE_AGENT); }
__device__ __forceinline__ unsigned xb_xcc_id() { return (unsigned)__builtin_amdgcn_s_getreg((3 << 11) | 20) & 0xFu; }
#define XB_SPIN(cond, bar) do { unsigned _sp = 0; while (cond) { __builtin_amdgcn_s_sleep(1); \
    if ((++_sp & 255u) == 0u) { if (xb_ld(&(bar)[XB_TMO])) break; if (_sp > XB_SPIN_CAP) { atomicAdd(&(bar)[XB_TMO], 1u); break; } } } } while (0)
struct XcdBarrier { unsigned* bar; unsigned x; volatile LAS unsigned* st; };
__device__ __forceinline__ XcdBarrier xcd_barrier_post(unsigned* bar, volatile LAS unsigned* st) {
    XcdBarrier b; b.bar = bar; b.x = xb_xcc_id(); b.st = st;
    if (threadIdx.x == 0) (void)xb_add(&bar[XB_XCNT(b.x)], 1u);
    return b;
}
__device__ __forceinline__ void xcd_barrier_complete(unsigned* bar, unsigned x, unsigned& nloc, unsigned& nx) {
    const unsigned G = gridDim.x * gridDim.y * gridDim.z;
    unsigned sum, cnt, mine, sp = 0u;
    for (;;) {
        sum = 0u; cnt = 0u; mine = 0u;
#pragma unroll
        for (unsigned j = 0; j < 16; ++j) { const unsigned c = xb_ld(&bar[XB_XCNT(j)]); sum += c; cnt += (c > 0u) ? 1u : 0u; mine = (j == x) ? c : mine; }
        if (sum == G) break;
        __builtin_amdgcn_s_sleep(1);
        if ((++sp & 255u) == 0u) { if (xb_ld(&bar[XB_TMO])) break; if (sp > XB_SPIN_CAP) { atomicAdd(&bar[XB_TMO], 1u); break; } }
    }
    nloc = mine > 0u ? mine : 1u; nx = cnt > 0u ? cnt : 1u;
}
__device__ __forceinline__ void xcd_barrier(const XcdBarrier& b) {
    asm volatile("s_waitcnt vmcnt(0)" ::: "memory");
    __syncthreads();
    if (threadIdx.x == 0) {
        unsigned* bar = b.bar;
        __builtin_amdgcn_s_waitcnt(0);
        unsigned nloc = b.st[0], nx = b.st[1];
        if (nloc == 0u) { xcd_barrier_complete(bar, b.x, nloc, nx); b.st[0] = nloc; b.st[1] = nx; }
        const unsigned old = xb_add(&bar[XB_XSUB(b.x)], 1u);
        const unsigned gen = old / nloc;
        if (old + 1u == (gen + 1u) * nloc) {
            __builtin_amdgcn_fence(__ATOMIC_RELEASE, "agent");
            asm volatile("s_waitcnt vmcnt(0)" ::: "memory");
            const unsigned og = xb_add(&bar[XB_TOP], 1u);
            const unsigned tg = og / nx;
            if (og + 1u == (tg + 1u) * nx) xb_add(&bar[XB_TOPGEN], 1u);
            else XB_SPIN(xb_ld(&bar[XB_TOPGEN]) == tg, bar);
            __builtin_amdgcn_fence(__ATOMIC_ACQUIRE, "agent");
            xb_add(&bar[XB_XGEN(b.x)], 1u);
            asm volatile("s_waitcnt vmcnt(0)" ::: "memory");
        } else {
            XB_SPIN(xb_ld(&bar[XB_XGEN(b.x)]) == gen, bar);
            __builtin_amdgcn_fence(__ATOMIC_ACQUIRE, "agent");
            asm volatile("s_waitcnt vmcnt(0)" ::: "memory");
        }
    }
    __syncthreads();
}

struct Params {
    const float *x, *c, *ctx, *c_ctx, *w_mod, *b_mod, *norm1_g, *norm2_g, *w_in, *w_out, *lb_logits, *a_norm_g, *rpb,
                *w_pool, *pool_scale, *w_router, *b_router, *w_gate, *w_up, *w_down, *final_g;
    float* out; unsigned char* ws; int ph_lo, ph_hi;
};

__device__ __forceinline__ void transpose_item(const float* W, int K, int N, bf16_t* WT, float* scr, int item, int lane) {
    const int nblk = N / 32, kb = item / nblk, nb = item % nblk, k0 = 64 * kb, n0 = 32 * nb;
#pragma unroll 8
    for (int i = 0; i < 32; ++i) { const int kk = 2 * i + (lane >> 5); scr[kk * 33 + (lane & 31)] = W[(size_t)(k0 + kk) * N + n0 + (lane & 31)]; }
    asm volatile("s_waitcnt lgkmcnt(0)" ::: "memory");
    const int c = lane & 7;
#pragma unroll
    for (int j = 0; j < 4; ++j) {
        const int n = (lane >> 3) + 8 * j; const float* s = scr + (8 * c) * 33 + n;
        uint4 o; o.x = pk2(s[0 * 33], s[1 * 33]); o.y = pk2(s[2 * 33], s[3 * 33]); o.z = pk2(s[4 * 33], s[5 * 33]); o.w = pk2(s[6 * 33], s[7 * 33]);
        *(uint4*)(WT + (size_t)(n0 + n) * K + k0 + 8 * c) = o;
    }
    asm volatile("s_waitcnt lgkmcnt(0)" ::: "memory");
}
__device__ __forceinline__ void convert_expert_item(const Params& p, int layer, bf16_t* WG, bf16_t* WU, bf16_t* WD, float* scr, int r, int lane) {
    const int mi = r >> 8, item = r & 255, mat = mi >> 4, e = mi & 15;
    const size_t eoff = (size_t)(layer * 16 + e) * 1024 * 512;
    if (mat == 0) transpose_item(p.w_gate + eoff, 1024, 512, WG + (size_t)e * 512 * 1024, scr, item, lane);
    else if (mat == 1) transpose_item(p.w_up + eoff, 1024, 512, WU + (size_t)e * 512 * 1024, scr, item, lane);
    else transpose_item(p.w_down + eoff, 512, 1024, WD + (size_t)e * 1024 * 512, scr, item, lane);
}
__device__ void phase_prep(const Params& p, unsigned char* smem) {
    const int t = tid_opaque(), lane = t & 63, w = t >> 6;
    float* modv = (float*)(p.ws + WS_MOD);
    {
        float* sc = (float*)smem; float* scc = sc + 1024; float* red = scc + 1024;
        for (int i = t; i < 1024; i += NTHREADS) { sc[i] = siluf_(p.c[i]); scc[i] = siluf_(p.c_ctx[i]); }
        __syncthreads();
        for (int u = blockIdx.x; u < 192; u += gridDim.x) {
            const int which = u / 96, col = (u % 96) * 64 + lane;
            const float* W = p.w_mod + (size_t)which * 1024 * 6144 + col;
            float a1 = 0.f, a2 = 0.f;
#pragma unroll 8
            for (int k = 128 * w; k < 128 * w + 128; ++k) { const float wv = W[(size_t)k * 6144]; a1 += sc[k] * wv; a2 += scc[k] * wv; }
            red[(w * 2 + 0) * 64 + lane] = a1; red[(w * 2 + 1) * 64 + lane] = a2;
            __syncthreads();
            if (t < 128) {
                const int sel = t >> 6, l = t & 63; float s = 0.f;
#pragma unroll
                for (int ww = 0; ww < 8; ++ww) s += red[(ww * 2 + sel) * 64 + l];
                const int cc = (u % 96) * 64 + l;
                s += p.b_mod[which * 6144 + cc];
                if (which == 0) modv[sel * 6144 + cc] = s; else if (sel == 0) modv[2 * 6144 + cc] = s;
            }
            __syncthreads();
        }
    }
    float* scr = (float*)smem + w * (64 * 33);
    const int gw = blockIdx.x * 8 + w, NGW = gridDim.x * 8;
    constexpr int I_IN = 16 * 128, I_OUT = 16 * 32, I_POOL = 4 * 32, I_EXP = 48 * 256;
    for (int it = gw; it < I_IN + I_OUT + I_POOL + I_EXP; it += NGW) {
        int r = it;
        if (r < I_IN) { transpose_item(p.w_in, 1024, 4096, (bf16_t*)(p.ws + WS_WIN), scr, r, lane); continue; } r -= I_IN;
        if (r < I_OUT) { transpose_item(p.w_out, 1024, 1024, (bf16_t*)(p.ws + WS_WOUT), scr, r, lane); continue; } r -= I_OUT;
        if (r < I_POOL) { const int g = r >> 5; transpose_item(p.w_pool + (size_t)g * 65536, 256, 256, (bf16_t*)(p.ws + WS_WPOOL) + (size_t)g * 65536, scr, r & 31, lane); continue; } r -= I_POOL;
        convert_expert_item(p, 0, (bf16_t*)(p.ws + WS_WG0), (bf16_t*)(p.ws + WS_WU0), (bf16_t*)(p.ws + WS_WD0), scr, r, lane);
    }
}

__device__ __forceinline__ void norm_mod_row(const float* xrow, const float* g, const float* shift, const float* scale, bf16_t* orow, int lane) {
    float4 v[4]; float s = 0.f;
#pragma unroll
    for (int j = 0; j < 4; ++j) { v[j] = ((const float4*)xrow)[lane + 64 * j]; s += (v[j].x * v[j].x + v[j].y * v[j].y) + (v[j].z * v[j].z + v[j].w * v[j].w); }
    const float rstd = rsqrtf(wave_sum(s) * (1.0f / D) + EPS);
#pragma unroll
    for (int j = 0; j < 4; ++j) {
        const int c4 = lane + 64 * j;
        const float4 gg = ((const float4*)g)[c4], sh = ((const float4*)shift)[c4], sc = ((const float4*)scale)[c4];
        const float a = v[j].x * rstd * gg.x * (1.f + sc.x) + sh.x, b = v[j].y * rstd * gg.y * (1.f + sc.y) + sh.y;
        const float c = v[j].z * rstd * gg.z * (1.f + sc.z) + sh.z, d = v[j].w * rstd * gg.w * (1.f + sc.w) + sh.w;
        uint2 o; o.x = pk2(a, b); o.y = pk2(c, d);
        ((uint2*)orow)[c4] = o;
    }
}
__device__ void phase_norm0(const Params& p) {
    const int t_ = tid_opaque(); const int lane = t_ & 63, gw = blockIdx.x * 8 + (t_ >> 6), NGW = gridDim.x * 8;
    const float* modv = (const float*)(p.ws + WS_MOD);
    bf16_t* U = (bf16_t*)(p.ws + WS_U);
    for (int r = gw; r < NTOK; r += NGW) {
        if (r < CTXL) norm_mod_row(p.ctx + (size_t)r * D, p.norm1_g, modv + 6144 + 0, modv + 6144 + 1024, U + (size_t)r * D, lane);
        else norm_mod_row(p.x + (size_t)(r - CTXL) * D, p.norm1_g, modv + 0, modv + 1024, U + (size_t)r * D, lane);
    }
}
__device__ void phase_norm1(const Params& p) {
    const int t_ = tid_opaque(); const int lane = t_ & 63, gw = blockIdx.x * 8 + (t_ >> 6), NGW = gridDim.x * 8;
    const float* modv = (const float*)(p.ws + WS_MOD) + 2 * 6144;
    bf16_t* U = (bf16_t*)(p.ws + WS_U);
    for (int r = gw; r < SEQ; r += NGW) norm_mod_row(p.out + (size_t)r * D, p.norm1_g + D, modv + 0, modv + 1024, U + (size_t)r * D, lane);
}
__device__ void phase_final(const Params& p) {
    const int t_ = tid_opaque(); const int lane = t_ & 63, gw = blockIdx.x * 8 + (t_ >> 6), NGW = gridDim.x * 8;
    for (int r = gw; r < SEQ; r += NGW) {
        float4* row = (float4*)(p.out + (size_t)r * D);
        float4 v[4]; float s = 0.f;
#pragma unroll
        for (int j = 0; j < 4; ++j) { v[j] = row[lane + 64 * j]; s += (v[j].x * v[j].x + v[j].y * v[j].y) + (v[j].z * v[j].z + v[j].w * v[j].w); }
        const float rstd = rsqrtf(wave_sum(s) * (1.0f / D) + EPS);
#pragma unroll
        for (int j = 0; j < 4; ++j) {
            const float4 gg = ((const float4*)p.final_g)[lane + 64 * j];
            float4 o; o.x = v[j].x * rstd * gg.x; o.y = v[j].y * rstd * gg.y; o.z = v[j].z * rstd * gg.z; o.w = v[j].w * rstd * gg.w;
            row[lane + 64 * j] = o;
        }
    }
}

constexpr int TM = 256, TN = 128, TK = 64, LDT = 72;
constexpr int A_STAGE = TM * LDT * 2, B_STAGE = TN * LDT * 2, STAGE_BYTES = A_STAGE + B_STAGE;
template <class RowA, class RowB, class Epi>
__device__ __forceinline__ void gemm_tile(unsigned char* smem, int K, const RowA& ra, const RowB& rb, const Epi& epi) {
    const int t = tid_opaque(), lane = t & 63, w = t >> 6, wm = w >> 1, wn = w & 1;
    const int lr = t >> 3, kc = t & 7;
    const bf16_t* ap[4];
#pragma unroll
    for (int i = 0; i < 4; ++i) ap[i] = ra(lr + 64 * i);
    f32x16 acc[2][2];
#pragma unroll
    for (int mi = 0; mi < 2; ++mi)
#pragma unroll
        for (int ni = 0; ni < 2; ++ni)
#pragma unroll
            for (int i = 0; i < 16; ++i) acc[mi][ni][i] = 0.f;
    uint4 sa[4], sb[2];
    const int nk = K / TK;
    auto gload = [&](int kt) {
        const int k0 = kt * TK + kc * 8;
#pragma unroll
        for (int i = 0; i < 4; ++i) sa[i] = ap[i] ? *(const uint4*)(ap[i] + k0) : make_uint4(0u, 0u, 0u, 0u);
#pragma unroll
        for (int i = 0; i < 2; ++i) sb[i] = *(const uint4*)(rb(lr + 64 * i, kt * TK) + kc * 8);
    };
    auto lstore = [&](int st) {
        bf16_t* As = (bf16_t*)(smem + st * STAGE_BYTES); bf16_t* Bs = As + TM * LDT;
#pragma unroll
        for (int i = 0; i < 4; ++i) *(uint4*)(As + (lr + 64 * i) * LDT + kc * 8) = sa[i];
#pragma unroll
        for (int i = 0; i < 2; ++i) *(uint4*)(Bs + (lr + 64 * i) * LDT + kc * 8) = sb[i];
    };
    __syncthreads();
    gload(0); lstore(0);
    __syncthreads();
    for (int kt = 0; kt < nk; ++kt) {
        if (kt + 1 < nk) gload(kt + 1);
        const bf16_t* As = (const bf16_t*)(smem + (kt & 1) * STAGE_BYTES); const bf16_t* Bs = As + TM * LDT;
#pragma unroll
        for (int kk = 0; kk < 4; ++kk) {
            bf16x8 xa[2], wb[2];
#pragma unroll
            for (int mi = 0; mi < 2; ++mi) xa[mi] = *(const bf16x8*)(As + (64 * wm + 32 * mi + (lane & 31)) * LDT + kk * 16 + 8 * (lane >> 5));
#pragma unroll
            for (int ni = 0; ni < 2; ++ni) wb[ni] = *(const bf16x8*)(Bs + (64 * wn + 32 * ni + (lane & 31)) * LDT + kk * 16 + 8 * (lane >> 5));
#pragma unroll
            for (int mi = 0; mi < 2; ++mi)
#pragma unroll
                for (int ni = 0; ni < 2; ++ni) acc[mi][ni] = __builtin_amdgcn_mfma_f32_32x32x16_bf16(wb[ni], xa[mi], acc[mi][ni], 0, 0, 0);
        }
        if (kt + 1 < nk) lstore((kt + 1) & 1);
        __syncthreads();
    }
    epi(acc, wm, wn, lane);
}

__device__ void phase_inproj(const Params& p, unsigned char* smem) {
    const bf16_t* U = (const bf16_t*)(p.ws + WS_U); const bf16_t* WT = (const bf16_t*)(p.ws + WS_WIN); bf16_t* PROJ = (bf16_t*)(p.ws + WS_PROJ);
    constexpr int NMT = NTOK / TM, NNT = INW / TN;
    for (int it = blockIdx.x; it < NMT * NNT; it += gridDim.x) {
        const int mt = it / NNT, nt = it % NNT;
        auto ra = [&](int r) -> const bf16_t* { return U + (size_t)(mt * TM + r) * D; };
        auto rb = [&](int n, int k0) -> const bf16_t* { return WT + (size_t)(nt * TN + n) * D + k0; };
        auto epi = [&](const f32x16 (&acc)[2][2], int wm, int wn, int lane) {
#pragma unroll
            for (int mi = 0; mi < 2; ++mi) {
                const int m = mt * TM + 64 * wm + 32 * mi + (lane & 31);
#pragma unroll
                for (int ni = 0; ni < 2; ++ni)
#pragma unroll
                    for (int g = 0; g < 4; ++g) {
                        const int n = nt * TN + 64 * wn + 32 * ni + 8 * g + 4 * (lane >> 5);
                        uint2 o; o.x = pk2(acc[mi][ni][4 * g + 0], acc[mi][ni][4 * g + 1]); o.y = pk2(acc[mi][ni][4 * g + 2], acc[mi][ni][4 * g + 3]);
                        *(uint2*)(PROJ + (size_t)m * INW + n) = o;
                    }
            }
        };
        gemm_tile(smem, D, ra, rb, epi);
    }
}
__device__ void phase_outproj(const Params& p, unsigned char* smem) {
    const bf16_t* AB = (const bf16_t*)(p.ws + WS_U); const bf16_t* WT = (const bf16_t*)(p.ws + WS_WOUT);
    const float* g1 = (const float*)(p.ws + WS_MOD) + 2 * 1024;
    constexpr int NMT = SEQ / TM, NNT = D / TN;
    for (int it = blockIdx.x; it < NMT * NNT; it += gridDim.x) {
        const int mt = it / NNT, nt = it % NNT;
        auto ra = [&](int r) -> const bf16_t* { return AB + (size_t)(mt * TM + r) * D; };
        auto rb = [&](int n, int k0) -> const bf16_t* { return WT + (size_t)(nt * TN + n) * D + k0; };
        auto epi = [&](const f32x16 (&acc)[2][2], int wm, int wn, int lane) {
#pragma unroll
            for (int mi = 0; mi < 2; ++mi) {
                const int m = mt * TM + 64 * wm + 32 * mi + (lane & 31);
#pragma unroll
                for (int ni = 0; ni < 2; ++ni)
#pragma unroll
                    for (int g = 0; g < 4; ++g) {
                        const int n = nt * TN + 64 * wn + 32 * ni + 8 * g + 4 * (lane >> 5);
                        const float4 xv = *(const float4*)(p.x + (size_t)m * D + n), gv = *(const float4*)(g1 + n);
                        float4 o; o.x = xv.x + gv.x * acc[mi][ni][4 * g + 0]; o.y = xv.y + gv.y * acc[mi][ni][4 * g + 1];
                        o.z = xv.z + gv.z * acc[mi][ni][4 * g + 2]; o.w = xv.w + gv.w * acc[mi][ni][4 * g + 3];
                        *(float4*)(p.out + (size_t)m * D + n) = o;
                    }
            }
        };
        gemm_tile(smem, D, ra, rb, epi);
    }
    const int t_ = tid_opaque(); const int lane = t_ & 63, w = t_ >> 6;
    __syncthreads();
    float* scr = (float*)smem + w * (64 * 33);
    for (int it = blockIdx.x * 8 + w; it < 48 * 256; it += gridDim.x * 8)
        convert_expert_item(p, 1, (bf16_t*)(p.ws + WS_WG1), (bf16_t*)(p.ws + WS_WU1), (bf16_t*)(p.ws + WS_WD1), scr, it, lane);
}
__device__ void phase_poolgemm(const Params& p, unsigned char* smem) {
    const bf16_t* PA = (const bf16_t*)(p.ws + WS_HL); const bf16_t* WT = (const bf16_t*)(p.ws + WS_WPOOL);
    const float* g1 = (const float*)(p.ws + WS_MOD) + 2 * 6144 + 2 * 1024;
    constexpr int NMT = SEQ / TM;
    for (int it = blockIdx.x; it < NMT * 8; it += gridDim.x) {
        const int mt = it >> 3, g = (it >> 1) & 3, nh = it & 1;
        auto ra = [&](int r) -> const bf16_t* { return PA + (size_t)(mt * TM + r) * D + 256 * g; };
        auto rb = [&](int n, int k0) -> const bf16_t* { return WT + (size_t)g * 65536 + (size_t)(nh * TN + n) * 256 + k0; };
        auto epi = [&](const f32x16 (&acc)[2][2], int wm, int wn, int lane) {
#pragma unroll
            for (int mi = 0; mi < 2; ++mi) {
                const int m = mt * TM + 64 * wm + 32 * mi + (lane & 31);
#pragma unroll
                for (int ni = 0; ni < 2; ++ni)
#pragma unroll
                    for (int gg = 0; gg < 4; ++gg) {
                        const int n = 256 * g + nh * TN + 64 * wn + 32 * ni + 8 * gg + 4 * (lane >> 5);
                        float4* op = (float4*)(p.out + (size_t)m * D + n);
                        const float4 hv = *op, gv = *(const float4*)(g1 + n), ps = *(const float4*)(p.pool_scale + n);
                        float4 o; o.x = hv.x + gv.x * ps.x * acc[mi][ni][4 * gg + 0]; o.y = hv.y + gv.y * ps.y * acc[mi][ni][4 * gg + 1];
                        o.z = hv.z + gv.z * ps.z * acc[mi][ni][4 * gg + 2]; o.w = hv.w + gv.w * ps.w * acc[mi][ni][4 * gg + 3];
                        *op = o;
                    }
            }
        };
        gemm_tile(smem, 256, ra, rb, epi);
    }
}

__device__ __forceinline__ int scan_row(int d, int pos) { return d == 0 ? pos : (pos < CTXL ? (CTXL - 1 - pos) : (CTXL + SEQ - 1 - (pos - CTXL))); }
__device__ __forceinline__ float lb_of(const Params& p, int d, int kw) { return sigmoidf_(p.lb_logits[1024 + d * 512 + kw] - p.lb_logits[d * 512 + kw]); }

__device__ void hgrn_passA_unit(const Params& p, unsigned char* smem, int u) {
    const int d = u >> 8, h = (u >> 6) & 3, c = u & 63;
    const int t = tid_opaque(), lane = t & 63, w = t >> 6, kq = lane & 3, vi = w * 16 + (lane >> 2);
    const bf16_t* PROJ = (const bf16_t*)(p.ws + WS_PROJ);
    float* fS = (float*)smem; float* vS = fS + 8 * 128; float* dS = vS + 8 * 128;
    const int ch = t & 127;
    const float lbv = lb_of(p, d, 128 * h + ch);
    float S[32];
#pragma unroll
    for (int i = 0; i < 32; ++i) S[i] = 0.f;
    float Dp = 1.f;
    for (int sub = 0; sub < 32; ++sub) {
        __syncthreads();
#pragma unroll
        for (int i = 0; i < 2; ++i) {
            const int j = (t >> 7) + 4 * i;
            const int row = scan_row(d, 256 * c + sub * 8 + j);
            const bf16_t* pr = PROJ + (size_t)row * INW;
            const float fr = bf2f(pr[512 + 512 * d + 128 * h + ch]);
            const float f = lbv + (1.f - lbv) * sigmoidf_(fr);
            fS[j * 128 + ch] = f; Dp *= f;
            vS[j * 128 + ch] = bf2f(pr[1536 + 128 * h + ch]);
        }
        __syncthreads();
#pragma unroll
        for (int j = 0; j < 8; ++j) {
            const float vv = vS[j * 128 + vi];
#pragma unroll
            for (int m = 0; m < 8; ++m) {
                const float4 f4 = *(const float4*)(fS + j * 128 + 16 * m + 4 * kq);
                S[4 * m + 0] = f4.x * S[4 * m + 0] + (1.f - f4.x) * vv;
                S[4 * m + 1] = f4.y * S[4 * m + 1] + (1.f - f4.y) * vv;
                S[4 * m + 2] = f4.z * S[4 * m + 2] + (1.f - f4.z) * vv;
                S[4 * m + 3] = f4.w * S[4 * m + 3] + (1.f - f4.w) * vv;
            }
        }
    }
    float* L = (float*)(p.ws + WS_HL) + (size_t)u * 16384;
#pragma unroll
    for (int m = 0; m < 8; ++m)
#pragma unroll
        for (int i = 0; i < 4; ++i) L[(16 * m + 4 * kq + i) * 128 + vi] = S[4 * m + i];
    __syncthreads();
    dS[(t >> 7) * 128 + ch] = Dp;
    __syncthreads();
    if (t < 128) ((float*)(p.ws + WS_HD))[(size_t)u * 128 + t] = (dS[t] * dS[128 + t]) * (dS[256 + t] * dS[384 + t]);
}
__device__ void phase_hgrnB(const Params& p) {
    const float* L = (const float*)(p.ws + WS_HL); const float* Dd = (const float*)(p.ws + WS_HD); float* SST = (float*)(p.ws + WS_HS);
    const int t_ = tid_opaque();
    for (int e = blockIdx.x * NTHREADS + t_; e < 8 * 16384; e += gridDim.x * NTHREADS) {
        const int dh = e >> 14, kv = e & 16383, k = kv >> 7;
        float S = 0.f;
#pragma unroll 8
        for (int c = 0; c < 64; ++c) {
            const size_t ui = (size_t)dh * 64 + c;
            S = Dd[ui * 128 + k] * S + L[ui * 16384 + kv];
            SST[ui * 16384 + kv] = S;
        }
    }
}
__device__ void hgrn_passC_unit(const Params& p, unsigned char* smem, int u) {
    const int h = u >> 6, jb = u & 63;
    const int t = tid_opaque(), lane = t & 63, w = t >> 6, kq = lane & 3, vi = w * 16 + (lane >> 2);
    const bf16_t* PROJ = (const bf16_t*)(p.ws + WS_PROJ);
    float* oF = (float*)smem;
    float* fS = oF + 256 * 128; float* qS = fS + 8 * 128; float* vS = qS + 8 * 128;
    const int ch = t & 127;
    const float qscale = 0.08838834764831845f;
    for (int d = 0; d < 2; ++d) {
        const int cs = (d == 0) ? (1 + jb) : (64 - jb);
        const float lbv = lb_of(p, d, 128 * h + ch);
        const float* S0 = (const float*)(p.ws + WS_HS) + ((size_t)(d * 4 + h) * 64 + (cs - 1)) * 16384;
        float S[32];
#pragma unroll
        for (int m = 0; m < 8; ++m)
#pragma unroll
            for (int i = 0; i < 4; ++i) S[4 * m + i] = S0[(16 * m + 4 * kq + i) * 128 + vi];
        for (int sub = 0; sub < 32; ++sub) {
            __syncthreads();
#pragma unroll
            for (int i = 0; i < 2; ++i) {
                const int j = (t >> 7) + 4 * i;
                const int row = scan_row(d, 256 * cs + sub * 8 + j);
                const bf16_t* pr = PROJ + (size_t)row * INW;
                const float fr = bf2f(pr[512 + 512 * d + 128 * h + ch]);
                fS[j * 128 + ch] = lbv + (1.f - lbv) * sigmoidf_(fr);
                qS[j * 128 + ch] = bf2f(pr[128 * h + ch]) * qscale;
                vS[j * 128 + ch] = bf2f(pr[1536 + 128 * h + ch]);
            }
            __syncthreads();
#pragma unroll
            for (int j = 0; j < 8; ++j) {
                const float vv = vS[j * 128 + vi];
                float o = 0.f;
#pragma unroll
                for (int m = 0; m < 8; ++m) {
                    const float4 f4 = *(const float4*)(fS + j * 128 + 16 * m + 4 * kq);
                    const float4 q4 = *(const float4*)(qS + j * 128 + 16 * m + 4 * kq);
                    S[4 * m + 0] = f4.x * S[4 * m + 0] + (1.f - f4.x) * vv; o += q4.x * S[4 * m + 0];
                    S[4 * m + 1] = f4.y * S[4 * m + 1] + (1.f - f4.y) * vv; o += q4.y * S[4 * m + 1];
                    S[4 * m + 2] = f4.z * S[4 * m + 2] + (1.f - f4.z) * vv; o += q4.z * S[4 * m + 2];
                    S[4 * m + 3] = f4.w * S[4 * m + 3] + (1.f - f4.w) * vv; o += q4.w * S[4 * m + 3];
                }
                o += __shfl_xor(o, 1); o += __shfl_xor(o, 2);
                const int ts = sub * 8 + j, tlb = (d == 0) ? ts : (255 - ts);
                if (kq == 0) { if (d == 0) oF[tlb * 128 + vi] = o; else oF[tlb * 128 + vi] += o; }
            }
        }
    }
    __syncthreads();
    bf16_t* AB = (bf16_t*)(p.ws + WS_U);
    for (int tl = w; tl < 256; tl += 8) {
        const float o0 = oF[tl * 128 + lane], o1 = oF[tl * 128 + 64 + lane];
        const float r = rsqrtf(wave_sum(o0 * o0 + o1 * o1) * (1.0f / 128.0f) + EPS);
        const int tok = 256 * jb + tl;
        const bf16_t* pr = PROJ + (size_t)(CTXL + tok) * INW + 2048 + 128 * h;
        const float g0 = bf2f(pr[lane]), g1 = bf2f(pr[64 + lane]);
        AB[(size_t)tok * D + 128 * h + lane] = (bf16_t)f2bf(o0 * r * p.a_norm_g[128 * h + lane] * siluf_(g0));
        AB[(size_t)tok * D + 128 * h + 64 + lane] = (bf16_t)f2bf(o1 * r * p.a_norm_g[128 * h + 64 + lane] * siluf_(g1));
    }
    __syncthreads();
}

__device__ void attn_unit(const Params& p, unsigned char* smem, int u) {
    const int h = u & 7, r = u >> 3;
    const int t = tid_opaque(), s = t & 7, qc = t >> 3;
    const bf16_t* PROJ = (const bf16_t*)(p.ws + WS_PROJ);
    bf16_t* Kw = (bf16_t*)smem; bf16_t* Vw = Kw + 512 * 64; float* bS = (float*)(smem + 131072);
    const int kr0 = min(max(r - 4, 0), 248), kc0 = min(max(qc - 8, 0), 48);
    __syncthreads();
#pragma unroll
    for (int i = 0; i < 8; ++i) {
        const int e = t + 512 * i, key = e >> 3, piece = e & 7;
        const int tok = (kr0 + (key >> 6)) * 64 + (key & 63);
        const bf16_t* pr = PROJ + (size_t)(CTXL + tok) * INW + 64 * h + 8 * piece;
        *(uint4*)(Kw + key * 64 + 8 * piece) = *(const uint4*)(pr + 3072);
        *(uint4*)(Vw + key * 64 + 8 * piece) = *(const uint4*)(pr + 3584);
    }
    if (t < 465) bS[t] = p.rpb[h * 465 + t];
    unsigned q[4];
    {
        const uint4 qv = *(const uint4*)(PROJ + (size_t)(CTXL + r * 64 + qc) * INW + 2560 + 64 * h + 8 * s);
        q[0] = pk2(bflo(qv.x) * 0.125f, bfhi(qv.x) * 0.125f); q[1] = pk2(bflo(qv.y) * 0.125f, bfhi(qv.y) * 0.125f);
        q[2] = pk2(bflo(qv.z) * 0.125f, bfhi(qv.z) * 0.125f); q[3] = pk2(bflo(qv.w) * 0.125f, bfhi(qv.w) * 0.125f);
    }
    __syncthreads();
    float mrun = -1e30f, lrun = 0.f, o[8];
#pragma unroll
    for (int i = 0; i < 8; ++i) o[i] = 0.f;
    auto group = [&](const bf16_t* Kb, const bf16_t* Vb, int key0, const float* bias) {
        float sc[16];
#pragma unroll
        for (int j = 0; j < 16; ++j) {
            const uint4 kv = *(const uint4*)(Kb + (key0 + j) * 64 + 8 * s);
            float dd = dot2bf(kv.x, q[0], 0.f); dd = dot2bf(kv.y, q[1], dd); dd = dot2bf(kv.z, q[2], dd); dd = dot2bf(kv.w, q[3], dd);
            dd += __shfl_xor(dd, 1); dd += __shfl_xor(dd, 2); dd += __shfl_xor(dd, 4);
            sc[j] = dd + (bias ? bias[j] : 0.f);
        }
        float gm = sc[0];
#pragma unroll
        for (int j = 1; j < 16; ++j) gm = fmaxf(gm, sc[j]);
        const float mn = fmaxf(mrun, gm), corr = __expf(mrun - mn);
        mrun = mn; lrun *= corr;
#pragma unroll
        for (int i = 0; i < 8; ++i) o[i] *= corr;
#pragma unroll
        for (int j = 0; j < 16; ++j) {
            const float pj = __expf(sc[j] - mn); lrun += pj;
            const uint4 vv = *(const uint4*)(Vb + (key0 + j) * 64 + 8 * s);
            o[0] += pj * bflo(vv.x); o[1] += pj * bfhi(vv.x); o[2] += pj * bflo(vv.y); o[3] += pj * bfhi(vv.y);
            o[4] += pj * bflo(vv.z); o[5] += pj * bfhi(vv.z); o[6] += pj * bflo(vv.w); o[7] += pj * bfhi(vv.w);
        }
    };
    for (int kr = 0; kr < 8; ++kr) {
        const int dr = (kr0 + kr) - r + 7, dc0 = kc0 - qc + 15;
        group(Kw, Vw, kr * 64 + kc0, bS + dr * 31 + dc0);
    }
    __syncthreads();
#pragma unroll
    for (int i = 0; i < 4; ++i) {
        const int e = t + 512 * i, key = e >> 3, piece = e & 7;
        const bf16_t* pr = PROJ + (size_t)key * INW + 64 * h + 8 * piece;
        *(uint4*)(Kw + key * 64 + 8 * piece) = *(const uint4*)(pr + 3072);
        *(uint4*)(Vw + key * 64 + 8 * piece) = *(const uint4*)(pr + 3584);
    }
    __syncthreads();
    for (int g = 0; g < 16; ++g) group(Kw, Vw, g * 16, nullptr);
    const float inv = 1.0f / lrun;
    uint4 ov; ov.x = pk2(o[0] * inv, o[1] * inv); ov.y = pk2(o[2] * inv, o[3] * inv); ov.z = pk2(o[4] * inv, o[5] * inv); ov.w = pk2(o[6] * inv, o[7] * inv);
    *(uint4*)((bf16_t*)(p.ws + WS_U) + (size_t)(r * 64 + qc) * D + 512 + 64 * h + 8 * s) = ov;
}
__device__ void phase_mix3(const Params& p, unsigned char* smem) {
    for (int u = blockIdx.x; u < 512 + 2048; u += gridDim.x) {
        if (u < 512) hgrn_passA_unit(p, smem, u); else attn_unit(p, smem, u - 512);
    }
}
__device__ void phase_hgrnC(const Params& p, unsigned char* smem) {
    for (int u = blockIdx.x; u < 256; u += gridDim.x) hgrn_passC_unit(p, smem, u);
}

__device__ void phase_route(const Params& p, unsigned char* smem, int layer) {
    const int t = tid_opaque(), lane = t & 63, w = t >> 6;
    float* wrT = (float*)smem;
    for (int i = t; i < 16384; i += NTHREADS) wrT[(i & 15) * 1024 + (i >> 4)] = p.w_router[i];
    __syncthreads();
    const float* modv = (const float*)(p.ws + WS_MOD) + (layer ? 2 * 6144 : 0);
    const float* sh = modv + 3 * 1024; const float* scl = modv + 4 * 1024; const float* g = p.norm2_g + layer * D;
    bf16_t* U2 = (bf16_t*)(p.ws + WS_U);
    unsigned* cnt = (unsigned*)(p.ws + WS_CTL + CTL_CNT_OFF) + layer * 32;
    int* list = (int*)(p.ws + WS_LIST); float2* wl = (float2*)(p.ws + WS_WL);
    for (int tok = blockIdx.x * 8 + w; tok < SEQ; tok += gridDim.x * 8) {
        const float4* row = (const float4*)(p.out + (size_t)tok * D);
        float4 v[4]; float s = 0.f;
#pragma unroll
        for (int j = 0; j < 4; ++j) { v[j] = row[lane + 64 * j]; s += (v[j].x * v[j].x + v[j].y * v[j].y) + (v[j].z * v[j].z + v[j].w * v[j].w); }
        const float rstd = rsqrtf(wave_sum(s) * (1.0f / D) + EPS);
        float lg[16];
#pragma unroll
        for (int e = 0; e < 16; ++e) lg[e] = 0.f;
#pragma unroll
        for (int j = 0; j < 4; ++j) {
            const int c4 = lane + 64 * j;
            const float4 gg = ((const float4*)g)[c4], s4 = ((const float4*)sh)[c4], c4v = ((const float4*)scl)[c4];
            float4 uu;
            uu.x = v[j].x * rstd * gg.x * (1.f + c4v.x) + s4.x; uu.y = v[j].y * rstd * gg.y * (1.f + c4v.y) + s4.y;
            uu.z = v[j].z * rstd * gg.z * (1.f + c4v.z) + s4.z; uu.w = v[j].w * rstd * gg.w * (1.f + c4v.w) + s4.w;
            uint2 o; o.x = pk2(uu.x, uu.y); o.y = pk2(uu.z, uu.w);
            ((uint2*)(U2 + (size_t)tok * D))[c4] = o;
            v[j] = uu;
        }
#pragma unroll
        for (int e = 0; e < 16; ++e) {
            float a = 0.f;
#pragma unroll
            for (int j = 0; j < 4; ++j) {
                const float4 wv = *(const float4*)(wrT + e * 1024 + 4 * (lane + 64 * j));
                a += (v[j].x * wv.x + v[j].y * wv.y) + (v[j].z * wv.z + v[j].w * wv.w);
            }
            lg[e] = wave_sum(a);
            asm volatile("" ::: "memory");
        }
        float sg[16], sb[16];
#pragma unroll
        for (int e = 0; e < 16; ++e) { sg[e] = sigmoidf_(lg[e]); sb[e] = sg[e] + p.b_router[e]; }
        float gs[4];
#pragma unroll
        for (int gI = 0; gI < 4; ++gI) {
            const float a = sb[4 * gI], b = sb[4 * gI + 1], c = sb[4 * gI + 2], d = sb[4 * gI + 3];
            gs[gI] = fmaxf(fmaxf(fmaxf(a + b, a + c), fmaxf(a + d, b + c)), fmaxf(b + d, c + d));
        }
        int grp = 0; float gbest = gs[0];
#pragma unroll
        for (int gI = 1; gI < 4; ++gI) if (gs[gI] > gbest) { gbest = gs[gI]; grp = gI; }
        float b4[4], s4v[4];
#pragma unroll
        for (int k = 0; k < 4; ++k) {
            b4[k] = grp == 0 ? sb[k] : grp == 1 ? sb[4 + k] : grp == 2 ? sb[8 + k] : sb[12 + k];
            s4v[k] = grp == 0 ? sg[k] : grp == 1 ? sg[4 + k] : grp == 2 ? sg[8 + k] : sg[12 + k];
        }
        int i1 = 0; float v1 = b4[0];
#pragma unroll
        for (int k = 1; k < 4; ++k) if (b4[k] > v1) { v1 = b4[k]; i1 = k; }
        int i2 = -1; float v2 = -1e30f;
#pragma unroll
        for (int k = 0; k < 4; ++k) if (k != i1 && b4[k] > v2) { v2 = b4[k]; i2 = k; }
        const int ea = min(i1, i2), eb = max(i1, i2);
        const float sa = ea == 0 ? s4v[0] : ea == 1 ? s4v[1] : s4v[2];
        const float sbv = eb == 1 ? s4v[1] : eb == 2 ? s4v[2] : s4v[3];
        const float inv = 1.0f / (sa + sbv);
        const int pidx = ea == 0 ? (eb - 1) : ea == 1 ? (eb + 1) : 5;
        const int cls = grp * 6 + pidx;
        if (lane == 0) {
            const unsigned slot = atomicAdd(&cnt[cls], 1u);
            list[cls * SEQ + slot] = tok;
            wl[cls * SEQ + slot] = make_float2(sa * inv, sbv * inv);
        }
    }
}
__device__ __forceinline__ int moe_tiles(const Params& p, int layer, int* tb, int* cn) {
    __syncthreads();
    if (tid_opaque() == 0) {
        const unsigned* cnt = (const unsigned*)(p.ws + WS_CTL + CTL_CNT_OFF) + layer * 32;
        int acc = 0;
        for (int c = 0; c < 24; ++c) { const int n = (int)__hip_atomic_load(cnt + c, __ATOMIC_RELAXED, __HIP_MEMORY_SCOPE_AGENT); cn[c] = n; tb[c] = acc; acc += (n + 255) >> 8; }
        tb[24] = acc;
    }
    __syncthreads();
    return tb[24];
}
__device__ __forceinline__ void class_experts(int cls, int& ea, int& eb) {
    const int grp = cls / 6, pi = cls % 6;
    const int la = pi < 3 ? 0 : (pi < 5 ? 1 : 2), lb = pi < 3 ? pi + 1 : (pi < 5 ? pi - 1 : 3);
    ea = grp * 4 + la; eb = grp * 4 + lb;
}
__device__ void phase_moe_up(const Params& p, unsigned char* smem, int layer) {
    int* tb = (int*)(smem + 2 * STAGE_BYTES); int* cn = tb + 32;
    const int MT = moe_tiles(p, layer, tb, cn);
    const bf16_t* U2 = (const bf16_t*)(p.ws + WS_U);
    const bf16_t* WG = (const bf16_t*)(p.ws + (layer ? WS_WG1 : WS_WG0)); const bf16_t* WU = (const bf16_t*)(p.ws + (layer ? WS_WU1 : WS_WU0));
    bf16_t* HB = (bf16_t*)(p.ws + WS_HBUF);
    const int* list = (const int*)(p.ws + WS_LIST); const float2* wl = (const float2*)(p.ws + WS_WL);
    for (int it = blockIdx.x; it < MT * 16; it += gridDim.x) {
        const int mt = it >> 4, nt = it & 15;
        int cls = 0;
        for (int c = 1; c < 24; ++c) if (tb[c] <= mt) cls = c;
        const int ti = mt - tb[cls], nrow = cn[cls] - ti * 256;
        int ea, eb; class_experts(cls, ea, eb);
        const int e = nt < 8 ? ea : eb, hc0 = 64 * (nt & 7);
        const int* lst = list + cls * SEQ + ti * 256;
        auto ra = [&](int r) -> const bf16_t* { return r < nrow ? U2 + (size_t)lst[r] * D : nullptr; };
        auto rb = [&](int n, int k0) -> const bf16_t* {
            const int wn_ = n >> 6, isup = (n >> 5) & 1, j = n & 31;
            return (isup ? WU : WG) + ((size_t)e * 512 + hc0 + 32 * wn_ + j) * D + k0;
        };
        auto epi = [&](const f32x16 (&acc)[2][2], int wm, int wn, int lane) {
#pragma unroll
            for (int mi = 0; mi < 2; ++mi) {
                const int r = 64 * wm + 32 * mi + (lane & 31);
                float wsel = 0.f;
                if (r < nrow) { const float2 ww = wl[cls * SEQ + ti * 256 + r]; wsel = nt < 8 ? ww.x : ww.y; }
#pragma unroll
                for (int g = 0; g < 4; ++g) {
                    float hv[4];
#pragma unroll
                    for (int j = 0; j < 4; ++j) { const float gt = acc[mi][0][4 * g + j], up = acc[mi][1][4 * g + j]; hv[j] = siluf_(gt) * up * wsel; }
                    uint2 o; o.x = pk2(hv[0], hv[1]); o.y = pk2(hv[2], hv[3]);
                    *(uint2*)(HB + (size_t)(mt * 256 + r) * D + 64 * nt + 32 * wn + 8 * g + 4 * (lane >> 5)) = o;
                }
            }
        };
        gemm_tile(smem, D, ra, rb, epi);
    }
}
__device__ void phase_moe_down(const Params& p, unsigned char* smem, int layer) {
    int* tb = (int*)(smem + 2 * STAGE_BYTES); int* cn = tb + 32;
    const int MT = moe_tiles(p, layer, tb, cn);
    const bf16_t* WD = (const bf16_t*)(p.ws + (layer ? WS_WD1 : WS_WD0));
    const bf16_t* HB = (const bf16_t*)(p.ws + WS_HBUF);
    const int* list = (const int*)(p.ws + WS_LIST);
    const float* g2 = (const float*)(p.ws + WS_MOD) + (layer ? 2 * 6144 : 0) + 5 * 1024;
    for (int it = blockIdx.x; it < MT * 8; it += gridDim.x) {
        const int mt = it >> 3, nt = it & 7;
        int cls = 0;
        for (int c = 1; c < 24; ++c) if (tb[c] <= mt) cls = c;
        const int ti = mt - tb[cls], nrow = cn[cls] - ti * 256;
        int ea, eb; class_experts(cls, ea, eb);
        const int* lst = list + cls * SEQ + ti * 256;
        auto ra = [&](int r) -> const bf16_t* { return HB + (size_t)(mt * 256 + r) * D; };
        auto rb = [&](int n, int k0) -> const bf16_t* {
            return k0 < 512 ? WD + ((size_t)ea * 1024 + nt * TN + n) * 512 + k0 : WD + ((size_t)eb * 1024 + nt * TN + n) * 512 + (k0 - 512);
        };
        auto epi = [&](const f32x16 (&acc)[2][2], int wm, int wn, int lane) {
#pragma unroll
            for (int mi = 0; mi < 2; ++mi) {
                const int r = 64 * wm + 32 * mi + (lane & 31);
                if (r < nrow) {
                    const int tok = lst[r];
#pragma unroll
                    for (int ni = 0; ni < 2; ++ni)
#pragma unroll
                        for (int g = 0; g < 4; ++g) {
                            const int n = nt * TN + 64 * wn + 32 * ni + 8 * g + 4 * (lane >> 5);
                            float4* op = (float4*)(p.out + (size_t)tok * D + n);
                            const float4 hv = *op, gv = *(const float4*)(g2 + n);
                            float4 o; o.x = hv.x + gv.x * acc[mi][ni][4 * g + 0]; o.y = hv.y + gv.y * acc[mi][ni][4 * g + 1];
                            o.z = hv.z + gv.z * acc[mi][ni][4 * g + 2]; o.w = hv.w + gv.w * acc[mi][ni][4 * g + 3];
                            *op = o;
                        }
                }
            }
        };
        gemm_tile(smem, D, ra, rb, epi);
    }
}

__device__ void phase_poolA(const Params& p) {
    const bf16_t* U = (const bf16_t*)(p.ws + WS_U); bf16_t* PA = (bf16_t*)(p.ws + WS_HL);
    const int t_ = tid_opaque();
    for (int e = blockIdx.x * NTHREADS + t_; e < SEQ * 128; e += gridDim.x * NTHREADS) {
        const int tok = e >> 7, c8 = e & 127, g = c8 >> 5, half = 1 << g;
        const int lo = max(tok - half, 0), hi = min(tok + half, SEQ);
        float s[8];
#pragma unroll
        for (int i = 0; i < 8; ++i) s[i] = 0.f;
        for (int r = lo; r < hi; ++r) {
            const uint4 v = *(const uint4*)(U + (size_t)r * D + 8 * c8);
            s[0] += bflo(v.x); s[1] += bfhi(v.x); s[2] += bflo(v.y); s[3] += bfhi(v.y); s[4] += bflo(v.z); s[5] += bfhi(v.z); s[6] += bflo(v.w); s[7] += bfhi(v.w);
        }
        const float ic = 1.0f / (float)(hi - lo);
        const uint4 me = *(const uint4*)(U + (size_t)tok * D + 8 * c8);
        uint4 o;
        o.x = pk2(s[0] * ic - bflo(me.x), s[1] * ic - bfhi(me.x)); o.y = pk2(s[2] * ic - bflo(me.y), s[3] * ic - bfhi(me.y));
        o.z = pk2(s[4] * ic - bflo(me.z), s[5] * ic - bfhi(me.z)); o.w = pk2(s[6] * ic - bflo(me.w), s[7] * ic - bfhi(me.w));
        *(uint4*)(PA + (size_t)tok * D + 8 * c8) = o;
    }
}

__global__ void __launch_bounds__(NTHREADS, 2) mega(Params p) {
    extern __shared__ __attribute__((aligned(16))) unsigned char smem[];
    volatile LAS unsigned* st = (volatile LAS unsigned*)(LAS unsigned char*)(smem + LDS_BYTES - 16);
    const int lo = p.ph_lo, hi = p.ph_hi;
    XcdBarrier bar; bar.bar = (unsigned*)(p.ws + WS_CTL); bar.x = 0; bar.st = st;
    if (hi - lo > 1) {
        if (threadIdx.x < 4) st[threadIdx.x] = 0u;
        __syncthreads();
        bar = xcd_barrier_post((unsigned*)(p.ws + WS_CTL), st);
    }
#define IN(k) (lo <= (k) && (k) < hi)
#define SEAM(k) do { if (IN(k) && IN((k) + 1)) xcd_barrier(bar); } while (0)
    if (IN(0)) phase_prep(p, smem);
    SEAM(0);
    if (IN(1)) phase_norm0(p);
    SEAM(1);
    if (IN(2)) phase_inproj(p, smem);
    SEAM(2);
    if (IN(3)) phase_mix3(p, smem);
    SEAM(3);
    if (IN(4)) phase_hgrnB(p);
    SEAM(4);
    if (IN(5)) phase_hgrnC(p, smem);
    SEAM(5);
    if (IN(6)) phase_outproj(p, smem);
    SEAM(6);
    if (IN(7)) phase_route(p, smem, 0);
    SEAM(7);
    if (IN(8)) phase_moe_up(p, smem, 0);
    SEAM(8);
    if (IN(9)) phase_moe_down(p, smem, 0);
    SEAM(9);
    if (IN(10)) phase_norm1(p);
    SEAM(10);
    if (IN(11)) phase_poolA(p);
    SEAM(11);
    if (IN(12)) phase_poolgemm(p, smem);
    SEAM(12);
    if (IN(13)) phase_route(p, smem, 1);
    SEAM(13);
    if (IN(14)) phase_moe_up(p, smem, 1);
    SEAM(14);
    if (IN(15)) phase_moe_down(p, smem, 1);
    SEAM(15);
    if (IN(16)) phase_final(p);
#undef IN
#undef SEAM
}

extern "C" void kernel_launch(void* const* d_in, const int* in_sizes, int n_in, void* d_out, int out_size, void* d_ws, size_t ws_size, hipStream_t stream) {
    static int grid = 0;
    if (grid == 0) {
        if (n_in != 21 || in_sizes[0] != SEQ * D || out_size != SEQ * D || ws_size < WS_END) {
            fprintf(stderr, "kernel_launch: unexpected shapes (n_in %d, in0 %d, out %d, ws %zu < %zu); nothing launched\n", n_in, n_in > 0 ? in_sizes[0] : -1, out_size, ws_size, (size_t)WS_END);
            grid = -1; return;
        }
        int dev = 0, cus = 0, per_cu = 0;
        if (hipGetDevice(&dev) != hipSuccess || hipDeviceGetAttribute(&cus, hipDeviceAttributeMultiprocessorCount, dev) != hipSuccess) { grid = -1; return; }
        if (hipFuncSetAttribute((const void*)mega, hipFuncAttributeMaxDynamicSharedMemorySize, LDS_BYTES) != hipSuccess) { fprintf(stderr, "kernel_launch: hipFuncSetAttribute failed\n"); grid = -1; return; }
        if (hipOccupancyMaxActiveBlocksPerMultiprocessor(&per_cu, (const void*)mega, NTHREADS, LDS_BYTES) != hipSuccess || per_cu < 1) {
            fprintf(stderr, "kernel_launch: occupancy query reports %d blocks per CU\n", per_cu); per_cu = 1;
        }
        (void)hipGetLastError();
        grid = cus;
    }
    if (grid < 0) return;
    (void)hipMemsetAsync((char*)d_ws + WS_CTL, 0, CTL_BYTES, stream);
    Params p{};
    const float** pp = (const float**)&p;
    for (int i = 0; i < 21; ++i) pp[i] = (const float*)d_in[i];
    p.out = (float*)d_out; p.ws = (unsigned char*)d_ws;
#if N_LAUNCH_MODE == 1
    p.ph_lo = 0; p.ph_hi = NPH;
    void* args[] = {&p};
    hipError_t e = hipLaunchCooperativeKernel((const void*)mega, dim3(grid), dim3(NTHREADS), args, LDS_BYTES, stream);
    if (e != hipSuccess) fprintf(stderr, "kernel_launch: cooperative launch failed: %s (grid %d)\n", hipGetErrorString(e), grid);
#else
    for (int ph = 0; ph < NPH; ++ph) {
        p.ph_lo = ph; p.ph_hi = ph + 1;
        hipLaunchKernelGGL(mega, dim3(grid), dim3(NTHREADS), LDS_BYTES, stream, p);
    }
#endif
}
```

```cpp
#include <hip/hip_runtime.h>
#include <cstdio>
#include <cstdint>

#ifndef REPEAT_PH
#define REPEAT_PH -1
#define REPEAT_N 0
#endif
#ifndef N_LAUNCH_MODE
#define N_LAUNCH_MODE 1
#endif

typedef unsigned short bf16_t;
typedef short bf16x8 __attribute__((ext_vector_type(8)));
typedef float f32x16 __attribute__((ext_vector_type(16)));
typedef __bf16 bf16x2_t __attribute__((ext_vector_type(2)));
namespace g8 { typedef float f32x4 __attribute__((ext_vector_type(4))); typedef unsigned u32x4 __attribute__((ext_vector_type(4))); }
#define LAS __attribute__((address_space(3)))

constexpr int D = 1024, SEQ = 16384, CTXL = 256, NTOK = SEQ + CTXL, INW = 4096;
constexpr int NPH = 19;
constexpr int NTHREADS = 512;
constexpr int LDS_BYTES = 147456;
constexpr float EPS = 1e-6f;

constexpr size_t MiB = 1024 * 1024;
constexpr size_t WS_CTL = 0;
constexpr size_t CTL_BYTES = 65536;
constexpr size_t CTL_CNT_OFF = 16384;
constexpr size_t WS_MOD = 65536;
constexpr size_t WS_WIN = 1 * MiB;
constexpr size_t WS_WOUT = 9 * MiB;
constexpr size_t WS_WPOOL = 11 * MiB;
constexpr size_t WS_WG0 = 12 * MiB;
constexpr size_t WS_WU0 = 28 * MiB;
constexpr size_t WS_WD0 = 44 * MiB;
constexpr size_t WS_U = 60 * MiB;
constexpr size_t WS_PROJ = 100 * MiB;
constexpr size_t WS_WG1 = WS_PROJ;
constexpr size_t WS_WU1 = WS_PROJ + 16 * MiB;
constexpr size_t WS_WD1 = WS_PROJ + 32 * MiB;
constexpr size_t WS_HBUF = WS_PROJ + 48 * MiB;
constexpr size_t WS_HL = 230 * MiB;
constexpr size_t WS_HS = 262 * MiB;
constexpr size_t WS_HD = 294 * MiB;
constexpr size_t WS_U2S = WS_HL;
constexpr size_t WS_LIST = 295 * MiB;
constexpr size_t WS_WL = 295 * MiB + 128 * 1024;
constexpr size_t WS_TOKINFO = 295 * MiB + 512 * 1024;
constexpr size_t WS_BLKCNT = 296 * MiB;
constexpr size_t WS_END = 297 * MiB;

__device__ __forceinline__ unsigned f2bf(float f) { return (unsigned)__builtin_bit_cast(unsigned short, (__bf16)f); }
__device__ __forceinline__ float bf2f(unsigned b) { return __uint_as_float(b << 16); }
__device__ __forceinline__ unsigned pk2(float lo, float hi) { bf16x2_t v; v[0] = (__bf16)lo; v[1] = (__bf16)hi; return __builtin_bit_cast(unsigned, v); }
__device__ __forceinline__ float bflo(unsigned w) { return __uint_as_float(w << 16); }
__device__ __forceinline__ float bfhi(unsigned w) { return __uint_as_float(w & 0xffff0000u); }
__device__ __forceinline__ float wave_sum(float v) {
#pragma unroll
    for (int o = 1; o < 64; o <<= 1) v += __shfl_xor(v, o);
    return v;
}
__device__ __forceinline__ int tid_opaque() { int t = threadIdx.x; asm volatile("" : "+v"(t)); return t; }
__device__ __forceinline__ float sigmoidf_(float x) { return 1.0f / (1.0f + __expf(-x)); }
__device__ __forceinline__ float siluf_(float x) { return x / (1.0f + __expf(-x)); }
__device__ __forceinline__ float silu_fast(float x) { return x * __builtin_amdgcn_rcpf(1.0f + __builtin_amdgcn_exp2f(-1.4426950408889634f * x)); }
__device__ __forceinline__ float dot2bf(unsigned a, unsigned b, float acc) {
    return __builtin_amdgcn_fdot2_f32_bf16(__builtin_bit_cast(bf16x2_t, a), __builtin_bit_cast(bf16x2_t, b), acc, false);
}

#define XB_TMO      128
#define XB_XCNT(j)  (256  + 64 * (j))
#define XB_XSUB(j)  (1280 + 64 * (j))
#define XB_XGEN(j)  (2304 + 64 * (j))
#define XB_TOP      3328
#define XB_TOPGEN   3392
#define XCD_BAR_WORDS 3456
#define XB_SPIN_CAP (1u << 22)
__device__ __forceinline__ unsigned xb_ld(unsigned* p)              { return __hip_atomic_load(p, __ATOMIC_RELAXED, __HIP_MEMORY_SCOPE_AGENT); }
__device__ __forceinline__ unsigned xb_add(unsigned* p, unsigned v) { return __hip_atomic_fetch_add(p, v, __ATOMIC_RELAXED, __HIP_MEMORY_SCOPE_AGENT); }
__device__ __forceinline__ unsigned xb_xcc_id() { return (unsigned)__builtin_amdgcn_s_getreg((3 << 11) | 20) & 0xFu; }
#define XB_SPIN(cond, bar) do { unsigned _sp = 0; while (cond) { \
    if ((++_sp & 255u) == 0u) { if (xb_ld(&(bar)[XB_TMO])) break; if (_sp > XB_SPIN_CAP) { atomicAdd(&(bar)[XB_TMO], 1u); break; } } } } while (0)
struct XcdBarrier { unsigned* bar; unsigned x; volatile LAS unsigned* st; };
__device__ __forceinline__ XcdBarrier xcd_barrier_post(unsigned* bar, volatile LAS unsigned* st) {
    XcdBarrier b; b.bar = bar; b.x = xb_xcc_id(); b.st = st;
    if (threadIdx.x == 0) (void)xb_add(&bar[XB_XCNT(b.x)], 1u);
    return b;
}
__device__ __forceinline__ void xcd_barrier_complete(unsigned* bar, unsigned x, unsigned& nloc, unsigned& nx) {
    const unsigned G = gridDim.x * gridDim.y * gridDim.z;
    unsigned sum, cnt, mine, sp = 0u;
    for (;;) {
        sum = 0u; cnt = 0u; mine = 0u;
#pragma unroll
        for (unsigned j = 0; j < 16; ++j) { const unsigned c = xb_ld(&bar[XB_XCNT(j)]); sum += c; cnt += (c > 0u) ? 1u : 0u; mine = (j == x) ? c : mine; }
        if (sum == G) break;
        __builtin_amdgcn_s_sleep(1);
        if ((++sp & 255u) == 0u) { if (xb_ld(&bar[XB_TMO])) break; if (sp > XB_SPIN_CAP) { atomicAdd(&bar[XB_TMO], 1u); break; } }
    }
    nloc = mine > 0u ? mine : 1u; nx = cnt > 0u ? cnt : 1u;
}
__device__ __forceinline__ void xcd_barrier(const XcdBarrier& b) {
    asm volatile("s_waitcnt vmcnt(0)" ::: "memory");
    __syncthreads();
    if (threadIdx.x == 0) {
        unsigned* bar = b.bar;
        __builtin_amdgcn_s_waitcnt(0);
        unsigned nloc = b.st[0], nx = b.st[1];
        if (nloc == 0u) { xcd_barrier_complete(bar, b.x, nloc, nx); b.st[0] = nloc; b.st[1] = nx; }
        const unsigned old = xb_add(&bar[XB_XSUB(b.x)], 1u);
        const unsigned gen = old / nloc;
        if (old + 1u == (gen + 1u) * nloc) {
            __builtin_amdgcn_fence(__ATOMIC_RELEASE, "agent");
            asm volatile("s_waitcnt vmcnt(0)" ::: "memory");
            const unsigned og = xb_add(&bar[XB_TOP], 1u);
            const unsigned tg = og / nx;
            if (og + 1u == (tg + 1u) * nx) xb_add(&bar[XB_TOPGEN], 1u);
            else XB_SPIN(xb_ld(&bar[XB_TOPGEN]) == tg, bar);
            __builtin_amdgcn_fence(__ATOMIC_ACQUIRE, "agent");
            xb_add(&bar[XB_XGEN(b.x)], 1u);
            asm volatile("s_waitcnt vmcnt(0)" ::: "memory");
        } else {
            XB_SPIN(xb_ld(&bar[XB_XGEN(b.x)]) == gen, bar);
            __builtin_amdgcn_fence(__ATOMIC_ACQUIRE, "agent");
            asm volatile("s_waitcnt vmcnt(0)" ::: "memory");
        }
    }
    __syncthreads();
}

struct Params {
    const float *x, *c, *ctx, *c_ctx, *w_mod, *b_mod, *norm1_g, *norm2_g, *w_in, *w_out, *lb_logits, *a_norm_g, *rpb,
                *w_pool, *pool_scale, *w_router, *b_router, *w_gate, *w_up, *w_down, *final_g;
    float* out; unsigned char* ws; int ph_lo, ph_hi;
};

typedef const __attribute__((address_space(4))) Params* PP;
__device__ __forceinline__ PP params_here() {
    unsigned long long v = (unsigned long long)__builtin_amdgcn_kernarg_segment_ptr();
    asm volatile("" : "+s"(v));
    return (PP)v;
}
__device__ __forceinline__ void transpose_item(const float* W, int K, int N, bf16_t* WT, float* scr, int item, int lane) {
    const int nblk = N / 64, kb = item / nblk, nb = item % nblk, k0 = 64 * kb, n0 = 64 * nb;
    g8::f32x4 tv[16];
#pragma unroll
    for (int i = 0; i < 16; ++i) tv[i] = __builtin_nontemporal_load((const g8::f32x4*)(W + (size_t)(k0 + 4 * i + (lane >> 4)) * N + n0) + (lane & 15));
#pragma unroll
    for (int i = 0; i < 16; ++i) {
        float* s = scr + (4 * i + (lane >> 4)) * 65 + 4 * (lane & 15);
        s[0] = tv[i][0]; s[1] = tv[i][1]; s[2] = tv[i][2]; s[3] = tv[i][3];
    }
    asm volatile("s_waitcnt lgkmcnt(0)" ::: "memory");
    const int c = lane & 7;
#pragma unroll
    for (int j = 0; j < 8; ++j) {
        const int n = (lane >> 3) + 8 * j; const float* s = scr + (8 * c) * 65 + n;
        uint4 o; o.x = pk2(s[0 * 65], s[1 * 65]); o.y = pk2(s[2 * 65], s[3 * 65]); o.z = pk2(s[4 * 65], s[5 * 65]); o.w = pk2(s[6 * 65], s[7 * 65]);
        *(uint4*)(WT + (size_t)(n0 + n) * K + k0 + 8 * c) = o;
    }
    asm volatile("s_waitcnt lgkmcnt(0)" ::: "memory");
}
__device__ __forceinline__ void convert_expert_item(PP p, int layer, bf16_t* WG, bf16_t* WU, bf16_t* WD, float* scr, int r, int lane) {
    const int mi = r >> 7, item = r & 127, mat = mi >> 4, e = mi & 15;
    const size_t eoff = (size_t)(layer * 16 + e) * 1024 * 512;
    if (mat == 0) transpose_item(p->w_gate + eoff, 1024, 512, WG + (size_t)e * 512 * 1024, scr, item, lane);
    else if (mat == 1) transpose_item(p->w_up + eoff, 1024, 512, WU + (size_t)e * 512 * 1024, scr, item, lane);
    else transpose_item(p->w_down + eoff, 512, 1024, WD + (size_t)e * 1024 * 512, scr, item, lane);
}
__device__ __forceinline__ void phase_prep(PP p, unsigned char* smem) {
    const int t = tid_opaque(), lane = t & 63, w = t >> 6;
    float* modv = (float*)(p->ws + WS_MOD);
    {
        float* sc = (float*)smem; float* scc = sc + 1024; float* red = scc + 1024;
        for (int i = t; i < 1024; i += NTHREADS) { sc[i] = siluf_(p->c[i]); scc[i] = siluf_(p->c_ctx[i]); }
        __syncthreads();
        for (int u = blockIdx.x; u < 192; u += gridDim.x) {
            const int which = u / 96, col = (u % 96) * 64 + lane;
            const float* W = p->w_mod + (size_t)which * 1024 * 6144 + col;
            float a1 = 0.f, a2 = 0.f;
#pragma unroll 8
            for (int k = 128 * w; k < 128 * w + 128; ++k) { const float wv = W[(size_t)k * 6144]; a1 += sc[k] * wv; a2 += scc[k] * wv; }
            red[(w * 2 + 0) * 64 + lane] = a1; red[(w * 2 + 1) * 64 + lane] = a2;
            __syncthreads();
            if (t < 128) {
                const int sel = t >> 6, l = t & 63; float s = 0.f;
#pragma unroll
                for (int ww = 0; ww < 8; ++ww) s += red[(ww * 2 + sel) * 64 + l];
                const int cc = (u % 96) * 64 + l;
                s += p->b_mod[which * 6144 + cc];
                if (which == 0) modv[sel * 6144 + cc] = s; else if (sel == 0) modv[2 * 6144 + cc] = s;
            }
            __syncthreads();
        }
    }
    float* scr = (float*)smem + w * (64 * 65);
    const int gw = blockIdx.x * 8 + w, NGW = gridDim.x * 8;
    constexpr int I_IN = 16 * 64, I_OUT = 16 * 16, I_POOL = 4 * 16;
    for (int it = gw; it < I_IN + I_OUT + I_POOL; it += NGW) {
        int r = it;
        if (r < I_IN) { transpose_item(p->w_in, 1024, 4096, (bf16_t*)(p->ws + WS_WIN), scr, r, lane); continue; } r -= I_IN;
        if (r < I_OUT) { transpose_item(p->w_out, 1024, 1024, (bf16_t*)(p->ws + WS_WOUT), scr, r, lane); continue; } r -= I_OUT;
        { const int g = r >> 4; transpose_item(p->w_pool + (size_t)g * 65536, 256, 256, (bf16_t*)(p->ws + WS_WPOOL) + (size_t)g * 65536, scr, r & 15, lane); }
    }
}

__device__ __forceinline__ void norm_mod_rows4(const float* const (&xrow)[4], const float* g, const float* const (&shift)[4], const float* const (&scale)[4], bf16_t* const (&orow)[4], int lane) {
    float4 v[4][4]; float s[4];
#pragma unroll
    for (int q = 0; q < 4; ++q)
#pragma unroll
        for (int j = 0; j < 4; ++j) v[q][j] = ((const float4*)xrow[q])[lane + 64 * j];
#pragma unroll
    for (int q = 0; q < 4; ++q) { s[q] = 0.f;
#pragma unroll
        for (int j = 0; j < 4; ++j) s[q] += (v[q][j].x * v[q][j].x + v[q][j].y * v[q][j].y) + (v[q][j].z * v[q][j].z + v[q][j].w * v[q][j].w); }
#pragma unroll
    for (int m = 1; m < 64; m <<= 1) {
#pragma unroll
        for (int q = 0; q < 4; ++q) s[q] += __shfl_xor(s[q], m);
    }
#pragma unroll
    for (int q = 0; q < 4; ++q) {
        const float rstd = rsqrtf(s[q] * (1.0f / D) + EPS);
#pragma unroll
        for (int j = 0; j < 4; ++j) {
            const int c4 = lane + 64 * j;
            const float4 gg = ((const float4*)g)[c4], sh = ((const float4*)shift[q])[c4], sc = ((const float4*)scale[q])[c4];
            const float a = v[q][j].x * rstd * gg.x * (1.f + sc.x) + sh.x, b = v[q][j].y * rstd * gg.y * (1.f + sc.y) + sh.y;
            const float c = v[q][j].z * rstd * gg.z * (1.f + sc.z) + sh.z, d = v[q][j].w * rstd * gg.w * (1.f + sc.w) + sh.w;
            uint2 o; o.x = pk2(a, b); o.y = pk2(c, d);
            ((uint2*)orow[q])[c4] = o;
        }
    }
}
__device__ __forceinline__ void phase_norm0(PP p) {
    const int t_ = tid_opaque(); const int lane = t_ & 63, gw = blockIdx.x * 8 + (t_ >> 6), NGW = gridDim.x * 8;
    const float* modv = (const float*)(p->ws + WS_MOD);
    bf16_t* U = (bf16_t*)(p->ws + WS_U);
    for (int r0 = gw * 4; r0 < NTOK; r0 += NGW * 4) {
        const float* xr[4]; const float* shp[4]; const float* scp[4]; bf16_t* orow[4];
#pragma unroll
        for (int q = 0; q < 4; ++q) {
            const int r = r0 + q;
            const bool isc = r < CTXL;
            xr[q] = isc ? p->ctx + (size_t)r * D : p->x + (size_t)(r - CTXL) * D;
            shp[q] = modv + (isc ? 6144 : 0); scp[q] = modv + (isc ? 6144 : 0) + 1024;
            orow[q] = U + (size_t)r * D;
        }
        norm_mod_rows4(xr, p->norm1_g, shp, scp, orow, lane);
    }
}
__device__ __forceinline__ void phase_final(PP p) {
    const int t_ = tid_opaque(); const int lane = t_ & 63, gw = blockIdx.x * 8 + (t_ >> 6), NGW = gridDim.x * 8;
    for (int r0 = gw * 4; r0 < SEQ; r0 += NGW * 4) {
        float4 v[4][4]; float s[4];
#pragma unroll
        for (int q = 0; q < 4; ++q)
#pragma unroll
            for (int j = 0; j < 4; ++j) v[q][j] = ((const float4*)(p->out + (size_t)(r0 + q) * D))[lane + 64 * j];
#pragma unroll
        for (int q = 0; q < 4; ++q) { s[q] = 0.f;
#pragma unroll
            for (int j = 0; j < 4; ++j) s[q] += (v[q][j].x * v[q][j].x + v[q][j].y * v[q][j].y) + (v[q][j].z * v[q][j].z + v[q][j].w * v[q][j].w); }
#pragma unroll
        for (int m = 1; m < 64; m <<= 1) {
#pragma unroll
            for (int q = 0; q < 4; ++q) s[q] += __shfl_xor(s[q], m);
        }
#pragma unroll
        for (int q = 0; q < 4; ++q) {
            const float rstd = rsqrtf(s[q] * (1.0f / D) + EPS);
#pragma unroll
            for (int j = 0; j < 4; ++j) {
                const float4 gg = ((const float4*)p->final_g)[lane + 64 * j];
                float4 o; o.x = v[q][j].x * rstd * gg.x; o.y = v[q][j].y * rstd * gg.y; o.z = v[q][j].z * rstd * gg.z; o.w = v[q][j].w * rstd * gg.w;
                ((float4*)(p->out + (size_t)(r0 + q) * D))[lane + 64 * j] = o;
            }
        }
    }
}
__device__ __forceinline__ void phase_normpool(PP p, unsigned char* smem) {
    const int t = tid_opaque(), lane = t & 63, w = t >> 6;
    const float* modv = (const float*)(p->ws + WS_MOD) + 2 * 6144;
    const float* g = p->norm1_g + D; const float* sh = modv; const float* scl = modv + 1024;
    bf16_t* PA = (bf16_t*)(p->ws + WS_HL);
    for (int hf = 0; hf < 2; ++hf) {
        const int T0 = blockIdx.x * 64 + 32 * hf, R0 = T0 - 8;
        __syncthreads();
#pragma unroll
        for (int bt = 0; bt < 2; ++bt) {
            float4 v[3][4];
#pragma unroll
            for (int q = 0; q < 3; ++q) {
                const int tok = min(max(R0 + w * 6 + bt * 3 + q, 0), SEQ - 1);
#pragma unroll
                for (int j = 0; j < 4; ++j) v[q][j] = ((const float4*)(p->out + (size_t)tok * D))[lane + 64 * j];
            }
#pragma unroll
            for (int q = 0; q < 3; ++q) {
                float s = 0.f;
#pragma unroll
                for (int j = 0; j < 4; ++j) s += (v[q][j].x * v[q][j].x + v[q][j].y * v[q][j].y) + (v[q][j].z * v[q][j].z + v[q][j].w * v[q][j].w);
                const float rstd = rsqrtf(wave_sum(s) * (1.0f / D) + EPS);
                bf16_t* lrow = (bf16_t*)smem + (w * 6 + bt * 3 + q) * D;
#pragma unroll
                for (int j = 0; j < 4; ++j) {
                    const int c4 = lane + 64 * j;
                    const float4 gg = ((const float4*)g)[c4], s4 = ((const float4*)sh)[c4], c4v = ((const float4*)scl)[c4];
                    uint2 o;
                    o.x = pk2(v[q][j].x * rstd * gg.x * (1.f + c4v.x) + s4.x, v[q][j].y * rstd * gg.y * (1.f + c4v.y) + s4.y);
                    o.y = pk2(v[q][j].z * rstd * gg.z * (1.f + c4v.z) + s4.z, v[q][j].w * rstd * gg.w * (1.f + c4v.w) + s4.w);
                    ((uint2*)lrow)[c4] = o;
                }
            }
        }
        __syncthreads();
        {
            const int c8 = t & 127, run = t >> 7, gq = c8 >> 5, half = 1 << gq;
            const bf16_t* base = (const bf16_t*)smem + 8 * c8;
            const int tok0 = T0 + 8 * run;
            float s[8];
#pragma unroll
            for (int i = 0; i < 8; ++i) s[i] = 0.f;
            int lo = max(tok0 - half, 0), hi = min(tok0 + half, SEQ);
            for (int r = lo; r < hi; ++r) {
                const uint4 vv = *(const uint4*)(base + (r - R0) * D);
                s[0] += bflo(vv.x); s[1] += bfhi(vv.x); s[2] += bflo(vv.y); s[3] += bfhi(vv.y); s[4] += bflo(vv.z); s[5] += bfhi(vv.z); s[6] += bflo(vv.w); s[7] += bfhi(vv.w);
            }
#pragma unroll
            for (int q = 0; q < 8; ++q) {
                const int tok = tok0 + q;
                if (q > 0) {
                    const int nlo = max(tok - half, 0), nhi = min(tok + half, SEQ);
                    if (nhi > hi) { const uint4 vv = *(const uint4*)(base + (hi - R0) * D);
                        s[0] += bflo(vv.x); s[1] += bfhi(vv.x); s[2] += bflo(vv.y); s[3] += bfhi(vv.y); s[4] += bflo(vv.z); s[5] += bfhi(vv.z); s[6] += bflo(vv.w); s[7] += bfhi(vv.w); }
                    if (nlo > lo) { const uint4 vv = *(const uint4*)(base + (lo - R0) * D);
                        s[0] -= bflo(vv.x); s[1] -= bfhi(vv.x); s[2] -= bflo(vv.y); s[3] -= bfhi(vv.y); s[4] -= bflo(vv.z); s[5] -= bfhi(vv.z); s[6] -= bflo(vv.w); s[7] -= bfhi(vv.w); }
                    lo = nlo; hi = nhi;
                }
                const float ic = 1.0f / (float)(hi - lo);
                const uint4 me = *(const uint4*)(base + (tok - R0) * D);
                uint4 o;
                o.x = pk2(s[0] * ic - bflo(me.x), s[1] * ic - bfhi(me.x)); o.y = pk2(s[2] * ic - bflo(me.y), s[3] * ic - bfhi(me.y));
                o.z = pk2(s[4] * ic - bflo(me.z), s[5] * ic - bfhi(me.z)); o.w = pk2(s[6] * ic - bflo(me.w), s[7] * ic - bfhi(me.w));
                *(uint4*)(PA + (size_t)tok * D + 8 * c8) = o;
            }
        }
    }
}

namespace g8 {
constexpr int BM = 256, BK = 64, HALF = 128, HTB = HALF * BK * 2, STAGE_BYTES = 8 * HTB, NXCD = 8, WGM = 8;
__device__ __forceinline__ int lds_byte(int r, int c) { const int st = (r >> 4) * 2 + (c >> 5), rr = r & 15, cc = c & 31, ob = rr * 64 + cc * 2; return st * 1024 + (ob ^ (((ob >> 9) & 1) << 5)); }
__device__ __forceinline__ void stage_rc(int b, int& R, int& C) { const int st = b / 1024, sb = b % 1024, swz = sb ^ (((sb >> 9) & 1) << 5); R = (st >> 1) * 16 + swz / 64; C = (st & 1) * 32 + (swz % 64) / 2; }
__device__ __forceinline__ int perm32(int rho) { const int n = rho >> 4, i = rho & 15; return 8 * (i >> 2) + 4 * n + (i & 3); }
__device__ __forceinline__ unsigned cvt_pk_bf16(float lo, float hi) { return pk2(lo, hi); }

struct Unit { unsigned a0, a1, b0, b1; int bd; int pm, pn, x0, x1; };
__device__ __forceinline__ bool tile_of(int i, int G, int c, int nM, int nN, int& pm, int& pn) {
    const int nwg = nM * nN; const long L = (long)i * G + c; if (L >= nwg) return false;
    int wgid = (int)L; { const int q = nwg / NXCD, r = nwg % NXCD, xcd = wgid % NXCD, off = wgid / NXCD; wgid = (xcd < r ? xcd * (q + 1) : r * (q + 1) + (xcd - r) * q) + off; }
    const int nig = WGM * nN, gid = wgid / nig, fm = gid * WGM, gsz = (nM - fm) < WGM ? (nM - fm) : WGM;
    pm = fm + ((wgid % nig) % gsz); pn = (wgid % nig) / gsz; return true;
}
template <class Epi, class Sched>
__device__ __forceinline__ void gemm_phase(LAS unsigned char* lds, const char* base, const int K, const int lda, const int ldb, const int tsplit, const Sched& S, const Epi& E) {
    const int tid = tid_opaque(), wid = __builtin_amdgcn_readfirstlane(tid >> 6), lane = tid & 63, wr = wid >> 2, wc = wid & 3, fr = lane & 15, fq = lane >> 4;
    const int nt = K / BK;
    unsigned voffA[2], voffB[2];
#pragma unroll
    for (int i = 0; i < 2; ++i) { int R, C; stage_rc(tid * 16 + i * 8192, R, C); const int Rb = Epi::PERM ? ((R & ~31) + perm32(R & 31)) : R;
        voffA[i] = (unsigned)(R * lda + C) * 2u; voffB[i] = (unsigned)(Rb * ldb + C) * 2u; }
    constexpr unsigned kstep = BK * 2;
    const unsigned ldsw = (unsigned)wid * 1024u;
    const int aoff = lds_byte(wr * 64 + fr, fq * 8), boff = lds_byte(wc * 32 + fr, fq * 8);
#define G8_SA(b, h) (((b) * 2 + (h)) * HTB)
#define G8_SB(b, h) ((4 + (b) * 2 + (h)) * HTB)
#define G8_STAGE(bufoff, goff, voff) do { _Pragma("unroll") for (int _i = 0; _i < 2; ++_i) \
        __builtin_amdgcn_global_load_lds((const unsigned*)(base + (size_t)((voff)[_i] + (unsigned)(goff))), (LAS unsigned*)(lds + (bufoff) + ldsw + _i * 8192), 16, 0, 0); } while (0)
#define G8_LDA(dst, b, h) do { _Pragma("unroll") for (int m = 0; m < 4; ++m) _Pragma("unroll") for (int k = 0; k < 2; ++k) dst[m][k] = *(const LAS bf16x8*)(lds + G8_SA(b, h) + aoff + m * 2048 + k * 1024); } while (0)
#define G8_LDB(dst, b, h) do { _Pragma("unroll") for (int n = 0; n < 2; ++n) _Pragma("unroll") for (int k = 0; k < 2; ++k) dst[n][k] = *(const LAS bf16x8*)(lds + G8_SB(b, h) + boff + n * 2048 + k * 1024); } while (0)
#define G8_MMA(ai, bj, At, Bt) do { __builtin_amdgcn_s_setprio(1); _Pragma("unroll") for (int m = 0; m < 4; ++m) _Pragma("unroll") for (int n = 0; n < 2; ++n) _Pragma("unroll") for (int k = 0; k < 2; ++k) \
        acc[ai][bj][m][n] = __builtin_amdgcn_mfma_f32_16x16x32_bf16(Bt[n][k], At[m][k], acc[ai][bj][m][n], 0, 0, 0); __builtin_amdgcn_s_setprio(0); } while (0)
#define G8_WAIT_V(n) asm volatile("s_waitcnt vmcnt(" #n ")" ::: "memory")
#define G8_WAIT_L(n) asm volatile("s_waitcnt lgkmcnt(" #n ")" ::: "memory")
#define G8_BAR __builtin_amdgcn_s_barrier()
#define G8_SCHED __builtin_amdgcn_sched_barrier(0)
#define G8_BK(u, h, tt) ((u).b##h + (unsigned)(tt) * kstep + (unsigned)(((tt) >= tsplit) ? (u).bd : 0))
#define G8_P(off) ((unsigned)(off))
    Unit cur, nxt; int ui = 0;
    if (!S.next(0, cur)) return;
    f32x4 acc[2][2][4][2];
#pragma unroll
    for (int a = 0; a < 2; ++a)
#pragma unroll
        for (int b = 0; b < 2; ++b)
#pragma unroll
            for (int m = 0; m < 4; ++m)
#pragma unroll
                for (int n = 0; n < 2; ++n) acc[a][b][m][n] = (f32x4){0.f, 0.f, 0.f, 0.f};
    bf16x8 At[4][2], B0[2][2], B1[2][2];
    asm volatile("s_waitcnt vmcnt(0) lgkmcnt(0)" ::: "memory");
    __syncthreads();
    G8_STAGE(G8_SB(0, 0), G8_P(G8_BK(cur, 0, 0)), voffB); G8_STAGE(G8_SB(0, 1), G8_P(G8_BK(cur, 1, 0)), voffB); G8_STAGE(G8_SA(0, 0), G8_P(cur.a0), voffA); G8_STAGE(G8_SA(0, 1), G8_P(cur.a1), voffA);
    if (wr == 1) G8_BAR;
    G8_WAIT_V(2); G8_BAR;
    G8_STAGE(G8_SB(1, 0), G8_P(G8_BK(cur, 0, 1)), voffB); G8_STAGE(G8_SA(1, 0), G8_P(cur.a0 + kstep), voffA); G8_STAGE(G8_SB(1, 1), G8_P(G8_BK(cur, 1, 1)), voffB);
    G8_WAIT_V(6); G8_BAR;
    for (;;) {
        const bool has_next = S.next(ui + 1, nxt);
        if (!has_next) nxt = cur;
        for (int t = 0; t < nt; t += 2) {
            const bool last = (t == nt - 2);
            const unsigned a1 = G8_P(cur.a1 + (unsigned)(t + 1) * kstep);
            const int t2 = last ? 0 : t + 2, t3 = t2 + 1;
            const unsigned a20 = G8_P((last ? nxt.a0 : cur.a0) + (unsigned)t2 * kstep), a21 = G8_P((last ? nxt.a1 : cur.a1) + (unsigned)t2 * kstep);
            const unsigned b20 = G8_P(last ? G8_BK(nxt, 0, t2) : G8_BK(cur, 0, t2)), b21 = G8_P(last ? G8_BK(nxt, 1, t2) : G8_BK(cur, 1, t2));
            const unsigned a30 = a20 + kstep;
            const unsigned b30 = G8_P(last ? G8_BK(nxt, 0, t3) : G8_BK(cur, 0, t3)), b31 = G8_P(last ? G8_BK(nxt, 1, t3) : G8_BK(cur, 1, t3));
            G8_LDB(B0, 0, 0); G8_LDB(B1, 0, 1); G8_SCHED; G8_LDA(At, 0, 0); G8_STAGE(G8_SA(1, 1), a1, voffA);
            G8_WAIT_V(8); G8_WAIT_L(0); G8_BAR; G8_MMA(0, 0, At, B0); G8_MMA(0, 1, At, B1); G8_BAR; G8_SCHED;
            G8_LDA(At, 0, 1); G8_STAGE(G8_SB(0, 0), b20, voffB); G8_STAGE(G8_SB(0, 1), b21, voffB); G8_STAGE(G8_SA(0, 0), a20, voffA);
            G8_WAIT_V(8); G8_WAIT_L(0); G8_BAR; G8_MMA(1, 0, At, B0); G8_MMA(1, 1, At, B1); G8_BAR; G8_SCHED;
            G8_LDB(B0, 1, 0); G8_LDB(B1, 1, 1); G8_SCHED; G8_LDA(At, 1, 0); G8_STAGE(G8_SA(0, 1), a21, voffA);
            G8_WAIT_V(8); G8_WAIT_L(0); G8_BAR; G8_MMA(0, 0, At, B0); G8_MMA(0, 1, At, B1); G8_BAR; G8_SCHED;
            G8_LDA(At, 1, 1); G8_STAGE(G8_SB(1, 0), b30, voffB); G8_STAGE(G8_SB(1, 1), b31, voffB); G8_STAGE(G8_SA(1, 0), a30, voffA);
            G8_WAIT_V(8); G8_WAIT_L(0); G8_BAR; G8_MMA(1, 0, At, B0); G8_MMA(1, 1, At, B1); G8_BAR; G8_SCHED;
        }
        if (wr == 0) G8_BAR;
        E(acc, cur, wr, wc, fr, fq);
        if (!has_next) break;
#pragma unroll
        for (int a = 0; a < 2; ++a)
#pragma unroll
            for (int b = 0; b < 2; ++b)
#pragma unroll
                for (int m = 0; m < 4; ++m)
#pragma unroll
                    for (int n = 0; n < 2; ++n) acc[a][b][m][n] = (f32x4){0.f, 0.f, 0.f, 0.f};
        cur = nxt; ++ui;
        if (wr == 1) G8_BAR;
    }
    G8_WAIT_V(0);
    G8_BAR;
#undef G8_SA
#undef G8_SB
#undef G8_STAGE
#undef G8_LDA
#undef G8_LDB
#undef G8_MMA
#undef G8_WAIT_V
#undef G8_WAIT_L
#undef G8_BAR
#undef G8_SCHED
#undef G8_BK
#undef G8_P
}
struct DenseSched {
    unsigned A, B, a_tile, b_tile; int nM, nN, G, c;
    __device__ __forceinline__ bool next(int i, Unit& u) const {
        int pm, pn; if (!tile_of(i, G, c, nM, nN, pm, pn)) return false;
        u.pm = pm; u.pn = pn; u.x0 = 0; u.x1 = 0; u.bd = 0;
        u.a0 = A + (unsigned)pm * a_tile; u.a1 = u.a0 + a_tile / 2; u.b0 = B + (unsigned)pn * b_tile; u.b1 = u.b0 + b_tile / 2; return true;
    }
};
}

__device__ __forceinline__ void convert_experts_on_idle(PP p, unsigned char* smem, int layer, int first, int mat_lo, int mat_hi) {
    const int G = gridDim.x;
    if ((int)blockIdx.x < first || first >= G) return;
    const int t_ = tid_opaque(); const int lane = t_ & 63, w = t_ >> 6;
    __syncthreads();
    float* scr = (float*)smem + w * (64 * 65);
    bf16_t* WG = (bf16_t*)(p->ws + (layer ? WS_WG1 : WS_WG0)); bf16_t* WU = (bf16_t*)(p->ws + (layer ? WS_WU1 : WS_WU0)); bf16_t* WD = (bf16_t*)(p->ws + (layer ? WS_WD1 : WS_WD0));
    for (int it = mat_lo * 2048 + ((int)blockIdx.x - first) * 8 + w; it < mat_hi * 2048; it += (G - first) * 8) convert_expert_item(p, layer, WG, WU, WD, scr, it, lane);
    __syncthreads();
}
struct EpiProj {
    static constexpr bool PERM = true;
    bf16_t* O;
    __device__ __forceinline__ void operator()(const g8::f32x4 (&acc)[2][2][4][2], const g8::Unit& u, int wr, int wc, int fr, int fq) const {
        const int row0 = u.pm * 256 + wr * 64 + fr, col0 = u.pn * 256 + wc * 32 + 8 * fq;
#pragma unroll
        for (int ai = 0; ai < 2; ++ai)
#pragma unroll
            for (int m = 0; m < 4; ++m) { bf16_t* rowp = O + (size_t)(row0 + ai * 128 + m * 16) * INW + col0;
#pragma unroll
                for (int bj = 0; bj < 2; ++bj) { const g8::f32x4 v0 = acc[ai][bj][m][0], v1 = acc[ai][bj][m][1];
                    g8::u32x4 w; w.x = g8::cvt_pk_bf16(v0[0], v0[1]); w.y = g8::cvt_pk_bf16(v0[2], v0[3]); w.z = g8::cvt_pk_bf16(v1[0], v1[1]); w.w = g8::cvt_pk_bf16(v1[2], v1[3]);
                    *(g8::u32x4*)(rowp + bj * 128) = w; } }
    }
};
__device__ __forceinline__ void phase_inproj(PP p, unsigned char* smem) {
    g8::DenseSched S; S.A = (unsigned)WS_U; S.B = (unsigned)WS_WIN; S.a_tile = 256u * D * 2; S.b_tile = 256u * D * 2;
    S.nM = NTOK / 256; S.nN = INW / 256; S.G = gridDim.x; S.c = blockIdx.x;
    EpiProj E; E.O = (bf16_t*)(p->ws + WS_PROJ);
    g8::gemm_phase((LAS unsigned char*)smem, (const char*)p->ws, D, D, D, 1 << 30, S, E);
    { const int G = gridDim.x, nun = (NTOK / 256) * (INW / 256), rem = nun % G; convert_experts_on_idle(p, smem, 0, rem == 0 ? 0 : rem, 0, 2); }
}
struct EpiOut {
    static constexpr bool PERM = false;
    const float* x; const float* g1; float* out;
    __device__ __forceinline__ void operator()(const g8::f32x4 (&acc)[2][2][4][2], const g8::Unit& u, int wr, int wc, int fr, int fq) const {
        const int row0 = u.pm * 256 + wr * 64 + fr, col0 = u.pn * 256 + wc * 32 + 4 * fq;
        g8::f32x4 gv[2][2];
#pragma unroll
        for (int bj = 0; bj < 2; ++bj)
#pragma unroll
            for (int n = 0; n < 2; ++n) gv[bj][n] = *(const g8::f32x4*)(g1 + col0 + bj * 128 + n * 16);
#pragma unroll
        for (int ai = 0; ai < 2; ++ai)
#pragma unroll
            for (int m = 0; m < 4; ++m) { const size_t off = (size_t)(row0 + ai * 128 + m * 16) * D + col0;
#pragma unroll
                for (int bj = 0; bj < 2; ++bj)
#pragma unroll
                    for (int n = 0; n < 2; ++n) { const g8::f32x4 xv = *(const g8::f32x4*)(x + off + bj * 128 + n * 16);
                        *(g8::f32x4*)(out + off + bj * 128 + n * 16) = xv + gv[bj][n] * acc[ai][bj][m][n]; }
                asm volatile("" ::: "memory"); }
    }
};
__device__ __forceinline__ void phase_outproj(PP p, unsigned char* smem) {
    g8::DenseSched S; S.A = (unsigned)WS_U; S.B = (unsigned)WS_WOUT; S.a_tile = 256u * D * 2; S.b_tile = 256u * D * 2;
    S.nM = SEQ / 256; S.nN = D / 256; S.G = gridDim.x; S.c = blockIdx.x;
    EpiOut E; E.x = p->x; E.g1 = (const float*)(p->ws + WS_MOD) + 2 * 1024; E.out = p->out;
    g8::gemm_phase((LAS unsigned char*)smem, (const char*)p->ws, D, D, D, 1 << 30, S, E);
}
struct PoolSched {
    int G, c;
    __device__ __forceinline__ bool next(int i, g8::Unit& u) const {
        const int L = i * G + c; if (L >= 256) return false;
        const int pm = L >> 2, g = L & 3;
        u.pm = pm; u.pn = g; u.x0 = 0; u.x1 = 0; u.bd = 0;
        u.a0 = (unsigned)WS_HL + ((unsigned)pm * 256 * D + 256 * g) * 2; u.a1 = u.a0 + 128u * D * 2; u.b0 = (unsigned)WS_WPOOL + (unsigned)g * 65536 * 2; u.b1 = u.b0 + 128u * 256 * 2; return true;
    }
};
struct EpiPool {
    static constexpr bool PERM = false;
    const float* g1; const float* ps; float* out;
    __device__ __forceinline__ void operator()(const g8::f32x4 (&acc)[2][2][4][2], const g8::Unit& u, int wr, int wc, int fr, int fq) const {
        const int row0 = u.pm * 256 + wr * 64 + fr, col0 = u.pn * 256 + wc * 32 + 4 * fq;
        g8::f32x4 gv[2][2];
#pragma unroll
        for (int bj = 0; bj < 2; ++bj)
#pragma unroll
            for (int n = 0; n < 2; ++n) gv[bj][n] = *(const g8::f32x4*)(g1 + col0 + bj * 128 + n * 16) * *(const g8::f32x4*)(ps + col0 + bj * 128 + n * 16);
#pragma unroll
        for (int ai = 0; ai < 2; ++ai)
#pragma unroll
            for (int m = 0; m < 4; ++m) { const size_t off = (size_t)(row0 + ai * 128 + m * 16) * D + col0;
#pragma unroll
                for (int bj = 0; bj < 2; ++bj)
#pragma unroll
                    for (int n = 0; n < 2; ++n) { g8::f32x4* op = (g8::f32x4*)(out + off + bj * 128 + n * 16); const g8::f32x4 hv = *op;
                        *op = hv + gv[bj][n] * acc[ai][bj][m][n]; }
                asm volatile("" ::: "memory"); }
    }
};
__device__ __forceinline__ void phase_poolgemm(PP p, unsigned char* smem) {
    PoolSched S; S.G = gridDim.x; S.c = blockIdx.x;
    EpiPool E; E.g1 = (const float*)(p->ws + WS_MOD) + 2 * 6144 + 2 * 1024; E.ps = p->pool_scale; E.out = p->out;
    g8::gemm_phase((LAS unsigned char*)smem, (const char*)p->ws, 256, D, 256, 1 << 30, S, E);
}

__device__ __forceinline__ int scan_row(int d, int pos) { return d == 0 ? pos : (pos < CTXL ? (CTXL - 1 - pos) : (CTXL + SEQ - 1 - (pos - CTXL))); }
__device__ __forceinline__ float lb_of(PP p, int d, int kw) { return sigmoidf_(p->lb_logits[1024 + d * 512 + kw] - p->lb_logits[d * 512 + kw]); }

constexpr int HG_QT = 0;
constexpr int HG_KT = 17408;
constexpr int HG_QS = 34816;
constexpr int HG_KE = 52224;
constexpr int HG_VT = 70656;
constexpr int HG_ST = 89088;
constexpr int HG_SEG = 123904;
constexpr int HG_DV = 125952;
typedef float f32x4v __attribute__((ext_vector_type(4)));
struct GateRaw { unsigned f[16], v[16], q[16]; };
template <bool FULL>
__device__ __forceinline__ void hgrn_gates_load(PP p, int d, int h, int pos0, int t, GateRaw& R) {
    const int k = t & 127, qd = t >> 7;
    const bf16_t* PROJ = (const bf16_t*)(p->ws + WS_PROJ);
#pragma unroll
    for (int i = 0; i < 16; ++i) {
        const int row = scan_row(d, pos0 + 16 * qd + i);
        const bf16_t* pr = PROJ + (size_t)row * INW + 128 * h + k;
        R.f[i] = pr[512 + 512 * d]; R.v[i] = pr[1536];
        if (FULL) R.q[i] = pr[0]; else R.q[i] = 0u;
    }
}
__device__ __forceinline__ void gate_raw_pin(GateRaw& R) {
#define PIN16(a) asm volatile("" : "+v"(a[0]), "+v"(a[1]), "+v"(a[2]), "+v"(a[3]), "+v"(a[4]), "+v"(a[5]), "+v"(a[6]), "+v"(a[7]), "+v"(a[8]), "+v"(a[9]), "+v"(a[10]), "+v"(a[11]), "+v"(a[12]), "+v"(a[13]), "+v"(a[14]), "+v"(a[15]))
    PIN16(R.f); PIN16(R.v); PIN16(R.q);
#undef PIN16
}
template <bool FULL>
__device__ __forceinline__ float hgrn_gates_compute(unsigned char* smem, const GateRaw& R, float lbv, int t) {
    const int k = t & 127, qd = t >> 7;
    float* seg = (float*)(smem + HG_SEG); float* Dv = (float*)(smem + HG_DV);
    float a[16], kk[16];
    const float L2E = 1.4426950408889634f;
#pragma unroll
    for (int i = 0; i < 16; ++i) {
        const float sg = __builtin_amdgcn_rcpf(1.0f + __builtin_amdgcn_exp2f(-L2E * bf2f(R.f[i])));
        const float f = lbv + (1.f - lbv) * sg;
        a[i] = __builtin_amdgcn_logf(f); kk[i] = 1.f - f;
    }
#pragma unroll
    for (int i = 1; i < 16; ++i) a[i] += a[i - 1];
    seg[qd * 128 + k] = a[15];
    __syncthreads();
    const float s0 = seg[k], s1 = seg[128 + k], s2 = seg[256 + k], s3 = seg[384 + k];
    const float off = qd == 0 ? 0.f : qd == 1 ? s0 : qd == 2 ? (s0 + s1) : (s0 + s1 + s2);
    const float bref = s0 + s1, btot = (s0 + s1) + (s2 + s3);
    const float dtot = __builtin_amdgcn_exp2f(btot);
    if (qd == 0) Dv[k] = dtot;
    unsigned kew[8], vw[8];
    bf16_t* QT = (bf16_t*)(smem + HG_QT); bf16_t* KT = (bf16_t*)(smem + HG_KT); bf16_t* QS = (bf16_t*)(smem + HG_QS);
    const float qscale = 0.08838834764831845f;
#pragma unroll
    for (int i = 0; i < 16; i += 2) {
        const float b0 = off + a[i], b1 = off + a[i + 1];
        kew[i >> 1] = g8::cvt_pk_bf16(kk[i] * __builtin_amdgcn_exp2f(btot - b0), kk[i + 1] * __builtin_amdgcn_exp2f(btot - b1));
        vw[i >> 1] = R.v[i] | (R.v[i + 1] << 16);
        if (FULL) {
            const float e0 = fminf(fmaxf(b0 - bref, -110.f), 110.f), e1 = fminf(fmaxf(b1 - bref, -110.f), 110.f);
            const float E0 = __builtin_amdgcn_exp2f(e0), E1 = __builtin_amdgcn_exp2f(e1);
            const float q0 = bf2f(R.q[i]) * qscale, q1 = bf2f(R.q[i + 1]) * qscale;
            const unsigned wq = g8::cvt_pk_bf16(q0 * E0, q1 * E1);
            const unsigned wk = g8::cvt_pk_bf16(kk[i] * __builtin_amdgcn_rcpf(E0), kk[i + 1] * __builtin_amdgcn_rcpf(E1));
            const unsigned ws_ = g8::cvt_pk_bf16(q0 * __builtin_amdgcn_exp2f(b0), q1 * __builtin_amdgcn_exp2f(b1));
            const int r0 = (16 * qd + i) * 136 + k, r1 = r0 + 136;
            QT[r0] = (bf16_t)(wq & 0xffffu); QT[r1] = (bf16_t)(wq >> 16);
            KT[r0] = (bf16_t)(wk & 0xffffu); KT[r1] = (bf16_t)(wk >> 16);
            QS[r0] = (bf16_t)(ws_ & 0xffffu); QS[r1] = (bf16_t)(ws_ >> 16);
        }
    }
    uint4* ke = (uint4*)(smem + HG_KE + k * 144 + qd * 32); uint4* vt = (uint4*)(smem + HG_VT + k * 144 + qd * 32);
    ke[0] = make_uint4(kew[0], kew[1], kew[2], kew[3]); ke[1] = make_uint4(kew[4], kew[5], kew[6], kew[7]);
    vt[0] = make_uint4(vw[0], vw[1], vw[2], vw[3]); vt[1] = make_uint4(vw[4], vw[5], vw[6], vw[7]);
    return dtot;
}
__device__ __forceinline__ void hgrn_state_update(unsigned char* smem, f32x16 (&sacc)[2], int w, int lane) {
    const int r = lane & 31, hh = lane >> 5, vt = w & 3;
    const float* Dv = (const float*)(smem + HG_DV);
#pragma unroll
    for (int kt2 = 0; kt2 < 2; ++kt2) {
        const int kt = 2 * (w >> 2) + kt2;
#pragma unroll
        for (int g = 0; g < 4; ++g) {
            const f32x4v dv = *(const f32x4v*)(Dv + 32 * kt + 8 * g + 4 * hh);
            sacc[kt2][4 * g + 0] *= dv[0]; sacc[kt2][4 * g + 1] *= dv[1]; sacc[kt2][4 * g + 2] *= dv[2]; sacc[kt2][4 * g + 3] *= dv[3];
        }
        {
            bf16x8 ao[4], bo[4];
#pragma unroll
            for (int js = 0; js < 4; ++js) {
                ao[js] = *(const bf16x8*)(smem + HG_KE + (32 * kt + r) * 144 + (16 * js + 8 * hh) * 2);
                bo[js] = *(const bf16x8*)(smem + HG_VT + (32 * vt + r) * 144 + (16 * js + 8 * hh) * 2);
            }
            __builtin_amdgcn_sched_barrier(0);
#pragma unroll
            for (int js = 0; js < 4; ++js) sacc[kt2] = __builtin_amdgcn_mfma_f32_32x32x16_bf16(ao[js], bo[js], sacc[kt2], 0, 0, 0);
        }
    }
}
__device__ __forceinline__ void hgrn_passA_unit(PP p, unsigned char* smem, int u) {
    const int d = u >> 8, h = (u >> 6) & 3, c = u & 63;
    const int t = tid_opaque(), lane = t & 63, w = t >> 6;
    const float lbv = lb_of(p, d, 128 * h + (t & 127));
    f32x16 sacc[2];
#pragma unroll
    for (int i = 0; i < 16; ++i) { sacc[0][i] = 0.f; sacc[1][i] = 0.f; }
    float Dtot = 1.f;
    GateRaw R;
    hgrn_gates_load<false>(p, d, h, 256 * c, t, R);
    for (int sub = 0; sub < 4; ++sub) {
        gate_raw_pin(R);
        Dtot *= hgrn_gates_compute<false>(smem, R, lbv, t);
        if (sub < 3) hgrn_gates_load<false>(p, d, h, 256 * c + 64 * (sub + 1), t, R);
        __syncthreads();
        hgrn_state_update(smem, sacc, w, lane);
    }
    float* L = (float*)(p->ws + WS_HL) + (size_t)u * 16384;
    const int r = lane & 31, hh = lane >> 5, vt = w & 3;
#pragma unroll
    for (int kt2 = 0; kt2 < 2; ++kt2)
#pragma unroll
        for (int e = 0; e < 16; ++e) L[(32 * (2 * (w >> 2) + kt2) + (e & 3) + 8 * (e >> 2) + 4 * hh) * 128 + 32 * vt + r] = sacc[kt2][e];
    if (t < 128) ((float*)(p->ws + WS_HD))[(size_t)u * 128 + t] = Dtot;
    __syncthreads();
}
__device__ __forceinline__ void phase_hgrnB(PP p) {
    const float* __restrict__ L = (const float*)(p->ws + WS_HL); const float* __restrict__ Dd = (const float*)(p->ws + WS_HD); float* __restrict__ SST = (float*)(p->ws + WS_HS);
    const int t_ = tid_opaque();
    for (int e = blockIdx.x * NTHREADS + t_; e < 8 * 16384; e += gridDim.x * NTHREADS) {
        const int dh = e >> 14, kv = e & 16383, k = kv >> 7;
        float S = 0.f;
        for (int c0 = 0; c0 < 64; c0 += 16) {
            float lv[16], dv[16];
#pragma unroll
            for (int c = 0; c < 16; ++c) { const size_t ui = (size_t)dh * 64 + c0 + c; lv[c] = L[ui * 16384 + kv]; dv[c] = Dd[ui * 128 + k]; }
#pragma unroll
            for (int c = 0; c < 16; ++c) { const size_t ui = (size_t)dh * 64 + c0 + c; S = dv[c] * S + lv[c]; SST[ui * 16384 + kv] = S; }
        }
    }
}
__device__ __forceinline__ void hgrn_passC_unit(PP p, unsigned char* smem, int u) {
    const int h = u >> 6, jb = u & 63;
    const int t = tid_opaque(), lane = t & 63, w = t >> 6, r = lane & 31, hh = lane >> 5, vt = w & 3, it = w >> 2;
    const bf16_t* PROJ = (const bf16_t*)(p->ws + WS_PROJ);
    float* OSF = (float*)(p->ws + WS_HL) + ((size_t)h * SEQ + 256 * jb) * 128;
    float* OSB = p->out + ((size_t)h * SEQ + 256 * jb) * 128;
    const float lb0 = lb_of(p, 0, 128 * h + (t & 127)), lb1 = lb_of(p, 1, 128 * h + (t & 127));
    GateRaw R;
    hgrn_gates_load<true>(p, 0, h, 256 * (1 + jb), t, R);
    f32x16 sacc[2];
    for (int step = 0; step < 8; ++step) {
        const int d = step >> 2, sub = step & 3;
        const int cs = (d == 0) ? (1 + jb) : (64 - jb);
        if (sub == 0) {
            const float* S0 = (const float*)(p->ws + WS_HS) + ((size_t)(d * 4 + h) * 64 + (cs - 1)) * 16384;
#pragma unroll
            for (int kt2 = 0; kt2 < 2; ++kt2)
#pragma unroll
                for (int e = 0; e < 16; ++e) sacc[kt2][e] = S0[(32 * (2 * it + kt2) + (e & 3) + 8 * (e >> 2) + 4 * hh) * 128 + 32 * vt + r];
        }
#pragma unroll
        for (int kt2 = 0; kt2 < 2; ++kt2)
#pragma unroll
            for (int g = 0; g < 4; ++g) {
                uint2 o; o.x = g8::cvt_pk_bf16(sacc[kt2][4 * g + 0], sacc[kt2][4 * g + 1]); o.y = g8::cvt_pk_bf16(sacc[kt2][4 * g + 2], sacc[kt2][4 * g + 3]);
                *(uint2*)(smem + HG_ST + (32 * vt + r) * 272 + (32 * (2 * it + kt2) + 8 * g + 4 * hh) * 2) = o;
            }
        gate_raw_pin(R);
        (void)hgrn_gates_compute<true>(smem, R, d ? lb1 : lb0, t);
        if (step < 7) { const int d2 = (step + 1) >> 2, sub2 = (step + 1) & 3; hgrn_gates_load<true>(p, d2, h, 256 * (d2 == 0 ? (1 + jb) : (64 - jb)) + 64 * sub2, t, R); }
        __syncthreads();
        f32x16 o;
#pragma unroll
        for (int e = 0; e < 16; ++e) o[e] = 0.f;
#pragma unroll
        for (int jt = 0; jt < 2; ++jt) {
            if (jt <= it) {
                f32x16 sT;
#pragma unroll
                for (int e = 0; e < 16; ++e) sT[e] = 0.f;
                {
                    bf16x8 ao[8], bo[8];
#pragma unroll
                    for (int ks = 0; ks < 8; ++ks) {
                        ao[ks] = *(const bf16x8*)(smem + HG_KT + (32 * jt + r) * 272 + (16 * ks + 8 * hh) * 2);
                        bo[ks] = *(const bf16x8*)(smem + HG_QT + (32 * it + r) * 272 + (16 * ks + 8 * hh) * 2);
                    }
                    __builtin_amdgcn_sched_barrier(0);
#pragma unroll
                    for (int ks = 0; ks < 8; ++ks) sT = __builtin_amdgcn_mfma_f32_32x32x16_bf16(ao[ks], bo[ks], sT, 0, 0, 0);
                }
                if (jt == it) {
#pragma unroll
                    for (int e = 0; e < 16; ++e) { const int j = (e & 3) + 8 * (e >> 2) + 4 * hh; sT[e] = (j <= r) ? sT[e] : 0.f; }
                }
#pragma unroll
                for (int s = 0; s < 2; ++s) {
                    bf16x8 pa;
                    const unsigned w0 = g8::cvt_pk_bf16(sT[8 * s + 0], sT[8 * s + 1]), w1 = g8::cvt_pk_bf16(sT[8 * s + 2], sT[8 * s + 3]), w2 = g8::cvt_pk_bf16(sT[8 * s + 4], sT[8 * s + 5]), w3 = g8::cvt_pk_bf16(sT[8 * s + 6], sT[8 * s + 7]);
                    pa[0] = (short)(w0 & 0xffff); pa[1] = (short)(w0 >> 16); pa[2] = (short)(w1 & 0xffff); pa[3] = (short)(w1 >> 16);
                    pa[4] = (short)(w2 & 0xffff); pa[5] = (short)(w2 >> 16); pa[6] = (short)(w3 & 0xffff); pa[7] = (short)(w3 >> 16);
                    const uint2 v0 = *(const uint2*)(smem + HG_VT + (32 * vt + r) * 144 + (32 * jt + 16 * s + 4 * hh) * 2);
                    const uint2 v1 = *(const uint2*)(smem + HG_VT + (32 * vt + r) * 144 + (32 * jt + 16 * s + 8 + 4 * hh) * 2);
                    bf16x8 vb;
                    vb[0] = (short)(v0.x & 0xffff); vb[1] = (short)(v0.x >> 16); vb[2] = (short)(v0.y & 0xffff); vb[3] = (short)(v0.y >> 16);
                    vb[4] = (short)(v1.x & 0xffff); vb[5] = (short)(v1.x >> 16); vb[6] = (short)(v1.y & 0xffff); vb[7] = (short)(v1.y >> 16);
                    o = __builtin_amdgcn_mfma_f32_32x32x16_bf16(pa, vb, o, 0, 0, 0);
                }
            }
        }
        {
            bf16x8 ao[8], bo[8];
#pragma unroll
            for (int ks = 0; ks < 8; ++ks) {
                ao[ks] = *(const bf16x8*)(smem + HG_QS + (32 * it + r) * 272 + (16 * ks + 8 * hh) * 2);
                bo[ks] = *(const bf16x8*)(smem + HG_ST + (32 * vt + r) * 272 + (16 * ks + 8 * hh) * 2);
            }
            __builtin_amdgcn_sched_barrier(0);
#pragma unroll
            for (int ks = 0; ks < 8; ++ks) o = __builtin_amdgcn_mfma_f32_32x32x16_bf16(ao[ks], bo[ks], o, 0, 0, 0);
        }
        {
            float* OS = d ? OSB : OSF;
#pragma unroll
            for (int e = 0; e < 16; ++e) {
                const int pos = 64 * sub + 32 * it + (e & 3) + 8 * (e >> 2) + 4 * hh;
                const int tl = (d == 0) ? pos : (255 - pos);
                OS[tl * 128 + 32 * vt + r] = o[e];
            }
        }
        hgrn_state_update(smem, sacc, w, lane);
        __syncthreads();
    }
    __syncthreads();
    bf16_t* AB = (bf16_t*)(p->ws + WS_U);
    const float ng0 = p->a_norm_g[128 * h + lane], ng1 = p->a_norm_g[128 * h + 64 + lane];
    for (int tb = 0; tb < 4; ++tb) {
        float o0[8], o1[8], g0[8], g1[8];
#pragma unroll
        for (int q = 0; q < 8; ++q) {
            const int tl = w * 32 + tb * 8 + q;
            o0[q] = OSF[tl * 128 + lane] + OSB[tl * 128 + lane]; o1[q] = OSF[tl * 128 + 64 + lane] + OSB[tl * 128 + 64 + lane];
            const bf16_t* pr = PROJ + (size_t)(CTXL + 256 * jb + tl) * INW + 2048 + 128 * h;
            g0[q] = bf2f(pr[lane]); g1[q] = bf2f(pr[64 + lane]);
        }
        float ss[8];
#pragma unroll
        for (int q = 0; q < 8; ++q) ss[q] = o0[q] * o0[q] + o1[q] * o1[q];
#pragma unroll
        for (int m = 1; m < 64; m <<= 1) {
#pragma unroll
            for (int q = 0; q < 8; ++q) ss[q] += __shfl_xor(ss[q], m);
        }
#pragma unroll
        for (int q = 0; q < 8; ++q) {
            const int tok = 256 * jb + w * 32 + tb * 8 + q;
            const float rr = rsqrtf(ss[q] * (1.0f / 128.0f) + EPS);
            AB[(size_t)tok * D + 128 * h + lane] = (bf16_t)f2bf(o0[q] * rr * ng0 * silu_fast(g0[q]));
            AB[(size_t)tok * D + 128 * h + 64 + lane] = (bf16_t)f2bf(o1[q] * rr * ng1 * silu_fast(g1[q]));
        }
    }
    __syncthreads();
}

constexpr int AT_VW = 0;
constexpr int AT_VC = 73728;
constexpr int AT_BS = 106496;
constexpr int AT_MG = 0;
typedef unsigned short u16x4 __attribute__((ext_vector_type(4)));
#define AT_TRREAD4(a0, a1, b0, b1, addr) asm volatile("ds_read_b64_tr_b16 %0, %4\n\tds_read_b64_tr_b16 %1, %4 offset:1024\n\tds_read_b64_tr_b16 %2, %4 offset:64\n\tds_read_b64_tr_b16 %3, %4 offset:1088\n\ts_waitcnt lgkmcnt(0)" \
    : "=&v"(a0), "=&v"(a1), "=&v"(b0), "=&v"(b1) : "v"(addr) : "memory")
__device__ __forceinline__ void attn_unit(PP p, unsigned char* smem, int u) {
    const int h = u >> 7, rp = u & 127, r0 = 2 * rp;
    const int t = tid_opaque(), lane = t & 63, w = __builtin_amdgcn_readfirstlane(t >> 6), qt = w & 3, part = w >> 2, ql = lane & 31, hh = lane >> 5;
    const bf16_t* PROJ = (const bf16_t*)(p->ws + WS_PROJ);
    float* bS = (float*)(smem + AT_BS);
    const int krb = min(max(r0 - 4, 0), 248);
    __syncthreads();
#pragma unroll
    for (int i = 0; i < 9; ++i) {
        const int e = t + 512 * i, key = e >> 3, piece = e & 7;
        const int tok = min(krb + (key >> 6), 255) * 64 + (key & 63);
        *(uint4*)(smem + AT_VW + key * 128 + piece * 16) = *(const uint4*)(PROJ + (size_t)(CTXL + tok) * INW + 3584 + 64 * h + 8 * piece);
    }
#pragma unroll
    for (int i = 0; i < 4; ++i) {
        const int e = t + 512 * i, key = e >> 3, piece = e & 7;
        *(uint4*)(smem + AT_VC + key * 128 + piece * 16) = *(const uint4*)(PROJ + (size_t)key * INW + 3584 + 64 * h + 8 * piece);
    }
    if (t < 465) bS[t] = p->rpb[h * 465 + t] * 1.4426950408889634f;
    const int qr = r0 + (ql >> 4), qcol = 16 * qt + (ql & 15);
    bf16x8 qf[4];
    {
        const bf16_t* qp = PROJ + (size_t)(CTXL + qr * 64 + qcol) * INW + 2560 + 64 * h + 8 * hh;
#pragma unroll
        for (int s = 0; s < 4; ++s) {
            const uint4 qv = *(const uint4*)(qp + 16 * s);
            const float qs_ = 0.125f * 1.4426950408889634f;
            const unsigned w0 = pk2(bflo(qv.x) * qs_, bfhi(qv.x) * qs_), w1 = pk2(bflo(qv.y) * qs_, bfhi(qv.y) * qs_);
            const unsigned w2 = pk2(bflo(qv.z) * qs_, bfhi(qv.z) * qs_), w3 = pk2(bflo(qv.w) * qs_, bfhi(qv.w) * qs_);
            qf[s][0] = (short)(w0 & 0xffff); qf[s][1] = (short)(w0 >> 16); qf[s][2] = (short)(w1 & 0xffff); qf[s][3] = (short)(w1 >> 16);
            qf[s][4] = (short)(w2 & 0xffff); qf[s][5] = (short)(w2 >> 16); qf[s][6] = (short)(w3 & 0xffff); qf[s][7] = (short)(w3 >> 16);
        }
    }
    const int kcs = min(max(16 * qt - 8, 0), 32);
    const int krq = min(max(qr - 4, 0), 248), kc0q = min(max(qcol - 8, 0), 48);
    unsigned cmask = 0u;
#pragma unroll
    for (int e = 0; e < 16; ++e) { const int kc = kcs + (e & 3) + 8 * (e >> 2) + 4 * hh; cmask |= ((unsigned)(kc - kc0q) < 16u) ? (1u << e) : 0u; }
    const int dcb = kcs + 4 * hh - qcol + 15;
    auto loadK = [&](int ti, uint4 (&kf)[4]) {
        int row;
        if (ti < 9) row = CTXL + min(krb + ti, 255) * 64 + kcs + ql; else row = 32 * (ti - 9) + ql;
        const bf16_t* kp = PROJ + (size_t)row * INW + 3072 + 64 * h + 8 * hh;
#pragma unroll
        for (int s = 0; s < 4; ++s) kf[s] = *(const uint4*)(kp + 16 * s);
    };
    const int tb = part ? 6 : 0, te = part ? 17 : 6;
    float mrun = -1e30f, lrun = 0.f;
    f32x16 oT[2];
#pragma unroll
    for (int e = 0; e < 16; ++e) { oT[0][e] = 0.f; oT[1][e] = 0.f; }
    auto scores = [&](int ti, const uint4 (&kf)[4], float (&sc)[16]) {
        f32x16 sT;
#pragma unroll
        for (int e = 0; e < 16; ++e) sT[e] = 0.f;
#pragma unroll
        for (int s = 0; s < 4; ++s) {
            bf16x8 ka;
            ka[0] = (short)(kf[s].x & 0xffff); ka[1] = (short)(kf[s].x >> 16); ka[2] = (short)(kf[s].y & 0xffff); ka[3] = (short)(kf[s].y >> 16);
            ka[4] = (short)(kf[s].z & 0xffff); ka[5] = (short)(kf[s].z >> 16); ka[6] = (short)(kf[s].w & 0xffff); ka[7] = (short)(kf[s].w >> 16);
            sT = __builtin_amdgcn_mfma_f32_32x32x16_bf16(ka, qf[s], sT, 0, 0, 0);
        }
        if (ti < 9) {
            const int kr = krb + ti;
            const bool rv = (kr >= krq) && (kr < krq + 8) && (kr < 256);
            const unsigned okm = rv ? cmask : 0u;
            const float* brow = bS + min(max((kr - qr + 7), 0), 14) * 31 + dcb;
            float bv[16];
#pragma unroll
            for (int e = 0; e < 16; ++e) bv[e] = brow[(e & 3) + 8 * (e >> 2)];
#pragma unroll
            for (int e = 0; e < 16; ++e) sc[e] = ((okm >> e) & 1u) ? (sT[e] + bv[e]) : -3e38f;
        } else if (ti < 17) {
#pragma unroll
            for (int e = 0; e < 16; ++e) sc[e] = sT[e];
        } else {
#pragma unroll
            for (int e = 0; e < 16; ++e) sc[e] = -3e38f;
        }
    };
    auto v_issue = [&](int ti, u16x4 (&vf)[8]) {
        const int tic = min(ti, 16);
        const int vbase = (tic < 9) ? (AT_VW + (tic * 64 + kcs) * 128) : (AT_VC + (32 * (tic - 9)) * 128);
        const unsigned va = (unsigned)(vbase + (4 * hh + ((lane & 15) >> 2)) * 128 + (16 * ((lane >> 4) & 1) + 4 * (lane & 3)) * 2);
        asm volatile("ds_read_b64_tr_b16 %0, %8\n\tds_read_b64_tr_b16 %1, %8 offset:1024\n\tds_read_b64_tr_b16 %2, %8 offset:64\n\tds_read_b64_tr_b16 %3, %8 offset:1088\n\t"
                     "ds_read_b64_tr_b16 %4, %8 offset:2048\n\tds_read_b64_tr_b16 %5, %8 offset:3072\n\tds_read_b64_tr_b16 %6, %8 offset:2112\n\tds_read_b64_tr_b16 %7, %8 offset:3136"
                     : "=&v"(vf[0]), "=&v"(vf[1]), "=&v"(vf[2]), "=&v"(vf[3]), "=&v"(vf[4]), "=&v"(vf[5]), "=&v"(vf[6]), "=&v"(vf[7]) : "v"(va) : "memory");
    };
    auto v_wait = [&](u16x4 (&va)[8], u16x4 (&vb)[8]) {
        asm volatile("s_waitcnt lgkmcnt(0)" : "+v"(va[0]), "+v"(va[1]), "+v"(va[2]), "+v"(va[3]), "+v"(va[4]), "+v"(va[5]), "+v"(va[6]), "+v"(va[7]),
                                               "+v"(vb[0]), "+v"(vb[1]), "+v"(vb[2]), "+v"(vb[3]), "+v"(vb[4]), "+v"(vb[5]), "+v"(vb[6]), "+v"(vb[7]) :: "memory");
    };
    auto pv_acc = [&](const u16x4 (&vf)[8], const float (&pv)[16]) {
#pragma unroll
        for (int s2 = 0; s2 < 2; ++s2) {
            const u16x4 a0 = vf[4 * s2 + 0], a1 = vf[4 * s2 + 1], b0 = vf[4 * s2 + 2], b1 = vf[4 * s2 + 3];
            bf16x8 va0, va1, pb;
            va0[0] = (short)a0[0]; va0[1] = (short)a0[1]; va0[2] = (short)a0[2]; va0[3] = (short)a0[3]; va0[4] = (short)a1[0]; va0[5] = (short)a1[1]; va0[6] = (short)a1[2]; va0[7] = (short)a1[3];
            va1[0] = (short)b0[0]; va1[1] = (short)b0[1]; va1[2] = (short)b0[2]; va1[3] = (short)b0[3]; va1[4] = (short)b1[0]; va1[5] = (short)b1[1]; va1[6] = (short)b1[2]; va1[7] = (short)b1[3];
            const unsigned w0 = g8::cvt_pk_bf16(pv[8 * s2 + 0], pv[8 * s2 + 1]), w1 = g8::cvt_pk_bf16(pv[8 * s2 + 2], pv[8 * s2 + 3]), w2 = g8::cvt_pk_bf16(pv[8 * s2 + 4], pv[8 * s2 + 5]), w3 = g8::cvt_pk_bf16(pv[8 * s2 + 6], pv[8 * s2 + 7]);
            pb[0] = (short)(w0 & 0xffff); pb[1] = (short)(w0 >> 16); pb[2] = (short)(w1 & 0xffff); pb[3] = (short)(w1 >> 16);
            pb[4] = (short)(w2 & 0xffff); pb[5] = (short)(w2 >> 16); pb[6] = (short)(w3 & 0xffff); pb[7] = (short)(w3 >> 16);
            oT[0] = __builtin_amdgcn_mfma_f32_32x32x16_bf16(va0, pb, oT[0], 0, 0, 0);
            oT[1] = __builtin_amdgcn_mfma_f32_32x32x16_bf16(va1, pb, oT[1], 0, 0, 0);
        }
    };
    auto pair = [&](int ti0, const uint4 (&k0)[4], const uint4 (&k1)[4]) {
        float s0[16], s1[16];
        u16x4 vfa[8], vfb[8];
        v_issue(ti0, vfa); v_issue(ti0 + 1, vfb);
        scores(ti0, k0, s0); scores(ti0 + 1, k1, s1);
        float mt = fmaxf(s0[0], s1[0]);
#pragma unroll
        for (int e = 1; e < 16; ++e) mt = fmaxf(mt, fmaxf(s0[e], s1[e]));
        mt = fmaxf(mt, __shfl_xor(mt, 32));
        const float mn = fmaxf(mrun, mt), corr = __builtin_amdgcn_exp2f(mrun - mn);
        const bool grew = mn > mrun;
        mrun = mn;
        float ls = 0.f;
#pragma unroll
        for (int e = 0; e < 16; ++e) {
            s0[e] = __builtin_amdgcn_exp2f(s0[e] - mn);
            s1[e] = __builtin_amdgcn_exp2f(s1[e] - mn);
            ls += s0[e] + s1[e];
        }
        ls += __shfl_xor(ls, 32);
        lrun = lrun * corr + ls;
        if (__any(grew)) {
#pragma unroll
            for (int e = 0; e < 16; ++e) { oT[0][e] *= corr; oT[1][e] *= corr; }
        }
        v_wait(vfa, vfb);
        pv_acc(vfa, s0); pv_acc(vfb, s1);
    };
    const int te2 = part ? 18 : 6;
    uint4 kA[2][4], kB[2][4];
#pragma unroll
    for (int j = 0; j < 2; ++j) loadK(min(tb + j, 16), kA[j]);
    __syncthreads();
    for (int g0 = tb; g0 < te2; g0 += 4) {
#pragma unroll
        for (int j = 0; j < 2; ++j) loadK(min(g0 + 2 + j, 16), kB[j]);
        pair(g0, kA[0], kA[1]);
#pragma unroll
        for (int j = 0; j < 2; ++j) loadK(min(g0 + 4 + j, 16), kA[j]);
        if (g0 + 2 < te2) pair(g0 + 2, kB[0], kB[1]);
    }
    __syncthreads();
    float* mg = (float*)(smem + AT_MG) + qt * 34 * 64;
    if (part == 1) {
        mg[0 * 64 + lane] = mrun; mg[1 * 64 + lane] = lrun;
#pragma unroll
        for (int e = 0; e < 16; ++e) { mg[(2 + e) * 64 + lane] = oT[0][e]; mg[(18 + e) * 64 + lane] = oT[1][e]; }
    }
    __syncthreads();
    if (part == 0) {
        const float m2 = mg[lane], l2 = mg[64 + lane];
        const float mn = fmaxf(mrun, m2), a1 = __builtin_amdgcn_exp2f(mrun - mn), a2 = __builtin_amdgcn_exp2f(m2 - mn);
        const float inv = 1.0f / (lrun * a1 + l2 * a2);
        bf16_t* op = (bf16_t*)(p->ws + WS_U) + (size_t)(qr * 64 + qcol) * D + 512 + 64 * h + 4 * hh;
#pragma unroll
        for (int dt = 0; dt < 2; ++dt)
#pragma unroll
            for (int g = 0; g < 4; ++g) {
                float o4[4];
#pragma unroll
                for (int j = 0; j < 4; ++j) o4[j] = (oT[dt][4 * g + j] * a1 + mg[(2 + 16 * dt + 4 * g + j) * 64 + lane] * a2) * inv;
                uint2 o; o.x = pk2(o4[0], o4[1]); o.y = pk2(o4[2], o4[3]);
                *(uint2*)(op + 32 * dt + 8 * g) = o;
            }
    }
}
__device__ __forceinline__ void phase_mix3(PP p, unsigned char* smem) {
    for (int u = blockIdx.x; u < 512 + 1024; u += gridDim.x) {
        if (u < 512) hgrn_passA_unit(p, smem, u); else attn_unit(p, smem, u - 512);
    }
}
__device__ __forceinline__ void phase_hgrnC(PP p, unsigned char* smem) {
    for (int u = blockIdx.x; u < 256; u += gridDim.x) hgrn_passC_unit(p, smem, u);
}

constexpr int MOE_TAB_OFF = 143360;
constexpr int CHUNK_TOK = 64;
__device__ __forceinline__ void class_experts(int cls, int& ea, int& eb) {
    const int grp = cls / 6, pi = cls % 6;
    const int la = pi < 3 ? 0 : (pi < 5 ? 1 : 2), lb = pi < 3 ? pi + 1 : (pi < 5 ? pi - 1 : 3);
    ea = grp * 4 + la; eb = grp * 4 + lb;
}
__device__ __forceinline__ void moe_norm_row(const float* hrow, const float* g, const float* sh, const float* scl, float4 (&v)[4], int lane) {
    float s = 0.f;
#pragma unroll
    for (int j = 0; j < 4; ++j) { v[j] = ((const float4*)hrow)[lane + 64 * j]; s += (v[j].x * v[j].x + v[j].y * v[j].y) + (v[j].z * v[j].z + v[j].w * v[j].w); }
    const float rstd = rsqrtf(wave_sum(s) * (1.0f / D) + EPS);
#pragma unroll
    for (int j = 0; j < 4; ++j) {
        const int c4 = lane + 64 * j;
        const float4 gg = ((const float4*)g)[c4], s4 = ((const float4*)sh)[c4], c4v = ((const float4*)scl)[c4];
        v[j].x = v[j].x * rstd * gg.x * (1.f + c4v.x) + s4.x; v[j].y = v[j].y * rstd * gg.y * (1.f + c4v.y) + s4.y;
        v[j].z = v[j].z * rstd * gg.z * (1.f + c4v.z) + s4.z; v[j].w = v[j].w * rstd * gg.w * (1.f + c4v.w) + s4.w;
    }
}
constexpr int WRT_LD = 1028;
__device__ __forceinline__ void phase_route1(PP p, unsigned char* smem, int layer) {
    const int t = tid_opaque(), lane = t & 63, w = t >> 6;
    float* wrT = (float*)smem;
    int* bc = (int*)(smem + 16 * WRT_LD * 4);
    float* sx = (float*)(smem + 16 * WRT_LD * 4 + 256);
    const int tokw = blockIdx.x * CHUNK_TOK + w * 8;
    float4 v[4][4];
#pragma unroll
    for (int q = 0; q < 4; ++q)
#pragma unroll
        for (int j = 0; j < 4; ++j) v[q][j] = ((const float4*)(p->out + (size_t)(tokw + q) * D))[lane + 64 * j];
    {
        float4 wv[8];
#pragma unroll
        for (int q = 0; q < 8; ++q) wv[q] = ((const float4*)p->w_router)[t + NTHREADS * q];
#pragma unroll
        for (int q = 0; q < 8; ++q) {
            const int i = t + NTHREADS * q, c = i >> 2, e4 = (i & 3) * 4;
            wrT[(e4 + 0) * WRT_LD + c] = wv[q].x; wrT[(e4 + 1) * WRT_LD + c] = wv[q].y; wrT[(e4 + 2) * WRT_LD + c] = wv[q].z; wrT[(e4 + 3) * WRT_LD + c] = wv[q].w;
        }
    }
    if (t < 32) bc[t] = 0;
    __syncthreads();
    const float* modv = (const float*)(p->ws + WS_MOD) + (layer ? 2 * 6144 : 0);
    const float* sh = modv + 3 * 1024; const float* scl = modv + 4 * 1024; const float* g = p->norm2_g + layer * D;
    float4* tokinfo = (float4*)(p->ws + WS_TOKINFO);
    bf16_t* U2T = (bf16_t*)(p->ws + WS_U);
    const float brt = p->b_router[lane & 15];
    for (int bt = 0; bt < 2; ++bt) {
        const int tok0 = tokw + bt * 4;
        float ss[4];
#pragma unroll
        for (int q = 0; q < 4; ++q) { ss[q] = 0.f;
#pragma unroll
            for (int j = 0; j < 4; ++j) ss[q] += (v[q][j].x * v[q][j].x + v[q][j].y * v[q][j].y) + (v[q][j].z * v[q][j].z + v[q][j].w * v[q][j].w); }
#pragma unroll
        for (int m = 1; m < 64; m <<= 1) {
#pragma unroll
            for (int q = 0; q < 4; ++q) ss[q] += __shfl_xor(ss[q], m);
        }
#pragma unroll
        for (int q = 0; q < 4; ++q) {
            const float rstd = rsqrtf(ss[q] * (1.0f / D) + EPS);
#pragma unroll
            for (int j = 0; j < 4; ++j) {
                const int c4 = lane + 64 * j;
                const float4 gg = ((const float4*)g)[c4], s4 = ((const float4*)sh)[c4], c4v = ((const float4*)scl)[c4];
                v[q][j].x = v[q][j].x * rstd * gg.x * (1.f + c4v.x) + s4.x; v[q][j].y = v[q][j].y * rstd * gg.y * (1.f + c4v.y) + s4.y;
                v[q][j].z = v[q][j].z * rstd * gg.z * (1.f + c4v.z) + s4.z; v[q][j].w = v[q][j].w * rstd * gg.w * (1.f + c4v.w) + s4.w;
                uint2 o; o.x = pk2(v[q][j].x, v[q][j].y); o.y = pk2(v[q][j].z, v[q][j].w);
                ((uint2*)(U2T + (size_t)(tok0 + q) * D))[c4] = o;
            }
        }
        float a[64];
        {
            typedef float f32x2 __attribute__((ext_vector_type(2)));
            f32x2 p01[4][4], p23[4][4];
#pragma unroll
            for (int j = 0; j < 4; ++j) {
                p01[j][0] = (f32x2){v[0][j].x, v[1][j].x}; p01[j][1] = (f32x2){v[0][j].y, v[1][j].y}; p01[j][2] = (f32x2){v[0][j].z, v[1][j].z}; p01[j][3] = (f32x2){v[0][j].w, v[1][j].w};
                p23[j][0] = (f32x2){v[2][j].x, v[3][j].x}; p23[j][1] = (f32x2){v[2][j].y, v[3][j].y}; p23[j][2] = (f32x2){v[2][j].z, v[3][j].z}; p23[j][3] = (f32x2){v[2][j].w, v[3][j].w};
            }
#pragma unroll
            for (int e = 0; e < 16; ++e) {
                f32x2 a01 = (f32x2){0.f, 0.f}, a23 = (f32x2){0.f, 0.f};
#pragma unroll
                for (int j = 0; j < 4; ++j) {
                    const float4 wv = *(const float4*)(wrT + e * WRT_LD + 4 * (lane + 64 * j));
                    a01 = p01[j][0] * wv.x + a01; a01 = p01[j][1] * wv.y + a01; a01 = p01[j][2] * wv.z + a01; a01 = p01[j][3] * wv.w + a01;
                    a23 = p23[j][0] * wv.x + a23; a23 = p23[j][1] * wv.y + a23; a23 = p23[j][2] * wv.z + a23; a23 = p23[j][3] * wv.w + a23;
                }
                a[e] = a01[0]; a[16 + e] = a01[1]; a[32 + e] = a23[0]; a[48 + e] = a23[1];
            }
        }
#define RS_STEP(N, M) { const bool hi_ = (lane & (M)) != 0; _Pragma("unroll") for (int k_ = 0; k_ < (N); ++k_) { \
            const float mine_ = hi_ ? a[(N) + k_] : a[k_], oth_ = hi_ ? a[k_] : a[(N) + k_]; a[k_] = mine_ + __shfl_xor(oth_, (M)); } }
        RS_STEP(32, 32) RS_STEP(16, 16) RS_STEP(8, 8) RS_STEP(4, 4) RS_STEP(2, 2) RS_STEP(1, 1)
#undef RS_STEP
        const float sgm = sigmoidf_(a[0]);
        sx[(w * 2 + 0) * 64 + lane] = sgm; sx[(w * 2 + 1) * 64 + lane] = sgm + brt;
        if (bt == 0) {
#pragma unroll
            for (int q = 0; q < 4; ++q)
#pragma unroll
                for (int j = 0; j < 4; ++j) v[q][j] = ((const float4*)(p->out + (size_t)(tokw + 4 + q) * D))[lane + 64 * j];
        }
        asm volatile("s_waitcnt lgkmcnt(0)" ::: "memory");
        if (lane < 4) {
            const float* sgp = sx + (w * 2 + 0) * 64 + lane * 16; const float* sbp = sx + (w * 2 + 1) * 64 + lane * 16;
            float sb[16], sg[16];
#pragma unroll
            for (int e = 0; e < 16; ++e) { sg[e] = sgp[e]; sb[e] = sbp[e]; }
            float gs[4];
#pragma unroll
            for (int gI = 0; gI < 4; ++gI) {
                const float a_ = sb[4 * gI], b_ = sb[4 * gI + 1], c_ = sb[4 * gI + 2], d_ = sb[4 * gI + 3];
                gs[gI] = fmaxf(fmaxf(fmaxf(a_ + b_, a_ + c_), fmaxf(a_ + d_, b_ + c_)), fmaxf(b_ + d_, c_ + d_));
            }
            int grp = 0; float gbest = gs[0];
#pragma unroll
            for (int gI = 1; gI < 4; ++gI) if (gs[gI] > gbest) { gbest = gs[gI]; grp = gI; }
            float b4[4], s4v[4];
#pragma unroll
            for (int k = 0; k < 4; ++k) {
                b4[k] = grp == 0 ? sb[k] : grp == 1 ? sb[4 + k] : grp == 2 ? sb[8 + k] : sb[12 + k];
                s4v[k] = grp == 0 ? sg[k] : grp == 1 ? sg[4 + k] : grp == 2 ? sg[8 + k] : sg[12 + k];
            }
            int i1 = 0; float v1 = b4[0];
#pragma unroll
            for (int k = 1; k < 4; ++k) if (b4[k] > v1) { v1 = b4[k]; i1 = k; }
            int i2 = -1; float v2 = -1e30f;
#pragma unroll
            for (int k = 0; k < 4; ++k) if (k != i1 && b4[k] > v2) { v2 = b4[k]; i2 = k; }
            const int ea = min(i1, i2), eb = max(i1, i2);
            const float sa = ea == 0 ? s4v[0] : ea == 1 ? s4v[1] : s4v[2];
            const float sbv = eb == 1 ? s4v[1] : eb == 2 ? s4v[2] : s4v[3];
            const float inv = 1.0f / (sa + sbv);
            const int pidx = ea == 0 ? (eb - 1) : ea == 1 ? (eb + 1) : 5;
            const int cls = grp * 6 + pidx;
            tokinfo[tok0 + lane] = make_float4(__int_as_float(cls), sa * inv, sbv * inv, 0.f);
            atomicAdd(&bc[cls], 1);
        }
    }
    __syncthreads();
    if (t < 32) ((int*)(p->ws + WS_BLKCNT))[layer * 8192 + blockIdx.x * 32 + t] = (t < 24) ? bc[t] : 0;
}
__device__ __forceinline__ void phase_route2(PP p, unsigned char* smem, int layer) {
    const int t = tid_opaque(), lane = t & 63, w = t >> 6;
    int* tb = (int*)(smem + MOE_TAB_OFF); int* tot = tb + 32;
    int* baseS = (int*)smem; int* clsS = baseS + 32; int* rankS = clsS + 64;
    const int* blkcnt = (const int*)(p->ws + WS_BLKCNT) + layer * 8192;
    const float4* tokinfo = (const float4*)(p->ws + WS_TOKINFO);
    const bf16_t* U2T = (const bf16_t*)(p->ws + WS_U);
    g8::u32x4 rw0[8], rw1[8];
#pragma unroll
    for (int i = 0; i < 8; ++i) {
        const g8::u32x4* rp_ = (const g8::u32x4*)(U2T + (size_t)(blockIdx.x * CHUNK_TOK + w * 8 + i) * D);
        rw0[i] = rp_[lane]; rw1[i] = rp_[64 + lane];
    }
    __syncthreads();
    {
        int* partB = rankS + 64; int* partT = partB + 512;
        const int c = t & 31, part = t >> 5;
        int base = 0, total = 0;
#pragma unroll
        for (int i = 0; i < 16; ++i) { const int b = part * 16 + i; const int v = blkcnt[b * 32 + c]; base += (b < (int)blockIdx.x) ? v : 0; total += v; }
        partB[part * 32 + c] = base; partT[part * 32 + c] = total;
        const int myc = __float_as_int(tokinfo[blockIdx.x * CHUNK_TOK + (t & 63)].x);
        __syncthreads();
        if (t < 24) {
            int bs = 0, ts = 0;
#pragma unroll
            for (int q = 0; q < 16; ++q) { bs += partB[q * 32 + t]; ts += partT[q * 32 + t]; }
            baseS[t] = bs; tot[t] = ts;
        }
        if (t >= 64 && t < 64 + CHUNK_TOK) clsS[t - 64] = myc;
    }
    __syncthreads();
    if (t == 0) {
        int* tinfo = tb + 64; int acc = 0;
        for (int c = 0; c < 24; ++c) {
            tb[c] = acc; const int n = (tot[c] + 255) >> 8; int ea, eb; class_experts(c, ea, eb);
            for (int k = 0; k < n; ++k) { tinfo[2 * (acc + k)] = ea | (eb << 8); tinfo[2 * (acc + k) + 1] = tot[c] - 256 * k; }
            acc += n;
        }
        tb[24] = acc;
    }
    if (t >= 64 && t < 64 + 24) { const int c = t - 64; int r = 0; for (int i = 0; i < CHUNK_TOK; ++i) if (clsS[i] == c) rankS[i] = r++; }
    __syncthreads();
    bf16_t* U2S = (bf16_t*)(p->ws + WS_U2S); int* list = (int*)(p->ws + WS_LIST); float2* wl = (float2*)(p->ws + WS_WL);
#pragma unroll
    for (int i = 0; i < 8; ++i) {
        const int li = w * 8 + i, tok = blockIdx.x * CHUNK_TOK + li;
        const int cls = clsS[li];
        const int pos = 256 * tb[cls] + baseS[cls] + rankS[li];
        g8::u32x4* dp = (g8::u32x4*)(U2S + (size_t)pos * D);
        dp[lane] = rw0[i]; dp[64 + lane] = rw1[i];
        if (lane == 0) { const float4 ti = tokinfo[tok]; list[pos] = tok; wl[pos] = make_float2(ti.y, ti.z); }
    }
}
struct MoeSched {
    const int* tb;
    unsigned A, W0, W1;
    int nN, G, c, mode;
    __device__ __forceinline__ bool next(int i, g8::Unit& u) const {
        const int MT = __builtin_amdgcn_readfirstlane(tb[24]);
        int pm, pn; if (!g8::tile_of(i, G, c, MT, nN, pm, pn)) return false;
        const int ee = __builtin_amdgcn_readfirstlane(tb[64 + 2 * pm]), nv = __builtin_amdgcn_readfirstlane(tb[64 + 2 * pm + 1]);
        const int ea = ee & 255, eb = ee >> 8;
        u.pm = pm; u.pn = pn; u.x0 = nv;
        u.a0 = A + (unsigned)pm * 256 * D * 2; u.a1 = u.a0 + 128u * D * 2;
        if (mode == 0) {
            const int e = pn < 4 ? ea : eb; const unsigned roff = ((unsigned)e * 512 + 128 * (pn & 3)) * D * 2;
            u.b0 = W0 + roff; u.b1 = W1 + roff; u.bd = 0; u.x1 = pn < 4 ? 0 : 1;
        } else {
            u.b0 = W0 + ((unsigned)ea * 1024 + 256 * pn) * 512 * 2; u.b1 = u.b0 + 128u * 512 * 2;
            u.bd = (eb - ea) * 1024 * 512 * 2 - 8 * 128; u.x1 = 0;
        }
        return true;
    }
};
struct EpiUp {
    static constexpr bool PERM = true;
    bf16_t* HB; const float2* wl;
    __device__ __forceinline__ void operator()(const g8::f32x4 (&acc)[2][2][4][2], const g8::Unit& u, int wr, int wc, int fr, int fq) const {
        const int row0 = u.pm * 256 + wr * 64 + fr, col0 = u.pn * 128 + wc * 32 + 8 * fq;
#pragma unroll
        for (int ai = 0; ai < 2; ++ai)
#pragma unroll
            for (int m = 0; m < 4; ++m) {
                const int row = row0 + ai * 128 + m * 16;
                const float2 ww = wl[row]; const float wsel = u.x1 ? ww.y : ww.x;
                float hv[8];
#pragma unroll
                for (int n = 0; n < 2; ++n)
#pragma unroll
                    for (int j = 0; j < 4; ++j) { const float gt = acc[ai][0][m][n][j], up = acc[ai][1][m][n][j]; hv[4 * n + j] = silu_fast(gt) * up * wsel; }
                g8::u32x4 o; o.x = g8::cvt_pk_bf16(hv[0], hv[1]); o.y = g8::cvt_pk_bf16(hv[2], hv[3]); o.z = g8::cvt_pk_bf16(hv[4], hv[5]); o.w = g8::cvt_pk_bf16(hv[6], hv[7]);
                *(g8::u32x4*)(HB + (size_t)row * D + col0) = o;
                asm volatile("" ::: "memory");
            }
    }
};
__device__ __forceinline__ void phase_moe_up(PP p, unsigned char* smem, int layer) {
    MoeSched S; S.tb = (const int*)(smem + MOE_TAB_OFF);
    S.A = (unsigned)WS_U2S; S.W0 = (unsigned)(layer ? WS_WG1 : WS_WG0); S.W1 = (unsigned)(layer ? WS_WU1 : WS_WU0);
    S.nN = 8; S.G = gridDim.x; S.c = blockIdx.x; S.mode = 0;
    EpiUp E; E.HB = (bf16_t*)(p->ws + WS_HBUF); E.wl = (const float2*)(p->ws + WS_WL);
    g8::gemm_phase((LAS unsigned char*)smem, (const char*)p->ws, D, D, D, 1 << 30, S, E);
    {
        const int G = gridDim.x, nun = __builtin_amdgcn_readfirstlane(S.tb[24]) * 8, rem = nun % G;
        convert_experts_on_idle(p, smem, layer, rem, 2, 3);
    }
}
struct EpiDown {
    static constexpr bool PERM = false;
    const int* list; const float* g2; float* out;
    __device__ __forceinline__ void operator()(const g8::f32x4 (&acc)[2][2][4][2], const g8::Unit& u, int wr, int wc, int fr, int fq) const {
        const int r0 = wr * 64 + fr, col0 = u.pn * 256 + wc * 32 + 4 * fq;
#pragma unroll
        for (int ai = 0; ai < 2; ++ai)
#pragma unroll
            for (int m = 0; m < 4; ++m) {
                const int r = r0 + ai * 128 + m * 16;
                if (r < u.x0) {
                    const int tok = list[u.pm * 256 + r];
                    float* orow = out + (size_t)tok * D + col0;
#pragma unroll
                    for (int bj = 0; bj < 2; ++bj)
#pragma unroll
                        for (int n = 0; n < 2; ++n) { g8::f32x4* op = (g8::f32x4*)(orow + bj * 128 + n * 16); const g8::f32x4 hv = *op; const g8::f32x4 gvv = *(const g8::f32x4*)(g2 + col0 + bj * 128 + n * 16); *op = hv + gvv * acc[ai][bj][m][n]; }
                }
                asm volatile("" ::: "memory");
            }
    }
};
__device__ __forceinline__ void phase_moe_down(PP p, unsigned char* smem, int layer) {
    MoeSched S; S.tb = (const int*)(smem + MOE_TAB_OFF);
    S.A = (unsigned)WS_HBUF; S.W0 = (unsigned)(layer ? WS_WD1 : WS_WD0); S.W1 = 0u;
    S.nN = 4; S.G = gridDim.x; S.c = blockIdx.x; S.mode = 1;
    EpiDown E; E.list = (const int*)(p->ws + WS_LIST); E.g2 = (const float*)(p->ws + WS_MOD) + (layer ? 2 * 6144 : 0) + 5 * 1024; E.out = p->out;
    g8::gemm_phase((LAS unsigned char*)smem, (const char*)p->ws, D, D, 512, 8, S, E);
    if (layer == 0) {
        const int G = gridDim.x, nun = __builtin_amdgcn_readfirstlane(S.tb[24]) * 4, rem = nun % G;
        convert_experts_on_idle(p, smem, 1, rem, 0, 2);
    }
}

__device__ __forceinline__ void phase_poolA(PP p) {
    const bf16_t* U = (const bf16_t*)(p->ws + WS_U); bf16_t* PA = (bf16_t*)(p->ws + WS_HL);
    const int t_ = tid_opaque();
    for (int e = blockIdx.x * NTHREADS + t_; e < SEQ * 128; e += gridDim.x * NTHREADS) {
        const int tok = e >> 7, c8 = e & 127, g = c8 >> 5, half = 1 << g;
        const int lo = max(tok - half, 0), hi = min(tok + half, SEQ);
        float s[8];
#pragma unroll
        for (int i = 0; i < 8; ++i) s[i] = 0.f;
        for (int r = lo; r < hi; ++r) {
            const uint4 v = *(const uint4*)(U + (size_t)r * D + 8 * c8);
            s[0] += bflo(v.x); s[1] += bfhi(v.x); s[2] += bflo(v.y); s[3] += bfhi(v.y); s[4] += bflo(v.z); s[5] += bfhi(v.z); s[6] += bflo(v.w); s[7] += bfhi(v.w);
        }
        const float ic = 1.0f / (float)(hi - lo);
        const uint4 me = *(const uint4*)(U + (size_t)tok * D + 8 * c8);
        uint4 o;
        o.x = pk2(s[0] * ic - bflo(me.x), s[1] * ic - bfhi(me.x)); o.y = pk2(s[2] * ic - bflo(me.y), s[3] * ic - bfhi(me.y));
        o.z = pk2(s[4] * ic - bflo(me.z), s[5] * ic - bfhi(me.z)); o.w = pk2(s[6] * ic - bflo(me.w), s[7] * ic - bfhi(me.w));
        *(uint4*)(PA + (size_t)tok * D + 8 * c8) = o;
    }
}

__global__ void __launch_bounds__(NTHREADS, 2) mega(Params pk) {
    extern __shared__ __attribute__((aligned(16))) unsigned char smem[];
    volatile LAS unsigned* st = (volatile LAS unsigned*)(LAS unsigned char*)(smem + LDS_BYTES - 16);
    PP p0 = params_here();
    const int lo = p0->ph_lo, hi = p0->ph_hi;
    XcdBarrier bar; bar.bar = (unsigned*)(p0->ws + WS_CTL); bar.x = 0; bar.st = st;
    if (hi - lo > 1) {
        if (threadIdx.x < 4) st[threadIdx.x] = 0u;
        __syncthreads();
        bar = xcd_barrier_post((unsigned*)(p0->ws + WS_CTL), st);
    }
#define IN(k) (lo <= (k) && (k) < hi)
#define SEAM(k) do { if (IN(k) && IN((k) + 1)) xcd_barrier(bar); } while (0)
#define RUN(k, call) do { if (IN(k)) { const int nr_ = (REPEAT_PH == (k)) ? REPEAT_N + 1 : 1; for (int r_ = 0; r_ < nr_; ++r_) { if (r_) xcd_barrier(bar); call; } } } while (0)
    RUN(0, phase_prep(params_here(), smem));
    SEAM(0);
    RUN(1, phase_norm0(params_here()));
    SEAM(1);
    RUN(2, phase_inproj(params_here(), smem));
    SEAM(2);
    RUN(3, phase_mix3(params_here(), smem));
    SEAM(3);
    RUN(4, phase_hgrnB(params_here()));
    SEAM(4);
    RUN(5, phase_hgrnC(params_here(), smem));
    SEAM(5);
    RUN(6, phase_outproj(params_here(), smem));
    SEAM(6);
    for (int layer = 0; layer < 2; ++layer) {
        if (layer == 1) {
            RUN(12, phase_normpool(params_here(), smem));
            SEAM(12);
            RUN(13, phase_poolgemm(params_here(), smem));
            SEAM(13);
        }
        const int pb = layer ? 14 : 7;
        RUN(pb, phase_route1(params_here(), smem, layer));
        SEAM(pb);
        RUN(pb + 1, phase_route2(params_here(), smem, layer));
        SEAM(pb + 1);
        RUN(pb + 2, phase_moe_up(params_here(), smem, layer));
        SEAM(pb + 2);
        RUN(pb + 3, phase_moe_down(params_here(), smem, layer));
        if (IN(pb + 3) && hi > pb + 4) xcd_barrier(bar);
    }
    RUN(18, phase_final(params_here()));
#undef IN
#undef SEAM
#undef RUN
}

extern "C" void kernel_launch(void* const* d_in, const int* in_sizes, int n_in, void* d_out, int out_size, void* d_ws, size_t ws_size, hipStream_t stream) {
    static int grid = 0;
    if (grid == 0) {
        if (n_in != 21 || in_sizes[0] != SEQ * D || out_size != SEQ * D || ws_size < WS_END) {
            fprintf(stderr, "kernel_launch: unexpected shapes (n_in %d, in0 %d, out %d, ws %zu < %zu); nothing launched\n", n_in, n_in > 0 ? in_sizes[0] : -1, out_size, ws_size, (size_t)WS_END);
            grid = -1; return;
        }
        int dev = 0, cus = 0, per_cu = 0;
        if (hipGetDevice(&dev) != hipSuccess || hipDeviceGetAttribute(&cus, hipDeviceAttributeMultiprocessorCount, dev) != hipSuccess) { grid = -1; return; }
        if (hipFuncSetAttribute((const void*)mega, hipFuncAttributeMaxDynamicSharedMemorySize, LDS_BYTES) != hipSuccess) { fprintf(stderr, "kernel_launch: hipFuncSetAttribute failed\n"); grid = -1; return; }
        if (hipOccupancyMaxActiveBlocksPerMultiprocessor(&per_cu, (const void*)mega, NTHREADS, LDS_BYTES) != hipSuccess || per_cu < 1) {
            fprintf(stderr, "kernel_launch: occupancy query reports %d blocks per CU\n", per_cu); per_cu = 1;
        }
        (void)hipGetLastError();
        grid = cus;
    }
    if (grid < 0) return;
    (void)hipMemsetAsync((char*)d_ws + WS_CTL, 0, CTL_BYTES, stream);
    Params p{};
    const float** pp = (const float**)&p;
    for (int i = 0; i < 21; ++i) pp[i] = (const float*)d_in[i];
    p.out = (float*)d_out; p.ws = (unsigned char*)d_ws;
#if N_LAUNCH_MODE == 1
    p.ph_lo = 0; p.ph_hi = NPH;
    void* args[] = {&p};
    hipError_t e = hipLaunchCooperativeKernel((const void*)mega, dim3(grid), dim3(NTHREADS), args, LDS_BYTES, stream);
    if (e != hipSuccess) fprintf(stderr, "kernel_launch: cooperative launch failed: %s (grid %d)\n", hipGetErrorString(e), grid);
#else
    for (int ph = 0; ph < NPH; ++ph) {
        p.ph_lo = ph; p.ph_hi = ph + 1;
        hipLaunchKernelGGL(mega, dim3(grid), dim3(NTHREADS), LDS_BYTES, stream, p);
    }
#endif
}
```

```cpp
#include <hip/hip_runtime.h>
#include <cstdio>
#include <cstdint>

#ifndef REPEAT_PH
#define REPEAT_PH -1
#define REPEAT_N 0
#endif
#ifndef N_LAUNCH_MODE
#define N_LAUNCH_MODE 1
#endif

typedef unsigned short bf16_t;
typedef short bf16x8 __attribute__((ext_vector_type(8)));
typedef float f32x16 __attribute__((ext_vector_type(16)));
typedef __bf16 bf16x2_t __attribute__((ext_vector_type(2)));
namespace g8 { typedef float f32x4 __attribute__((ext_vector_type(4))); typedef unsigned u32x4 __attribute__((ext_vector_type(4))); }
#define LAS __attribute__((address_space(3)))

constexpr int D = 1024, SEQ = 16384, CTXL = 256, NTOK = SEQ + CTXL, INW = 4096;
constexpr int NPH = 19;
constexpr int NTHREADS = 512;
constexpr int LDS_BYTES = 147456;
constexpr float EPS = 1e-6f;

constexpr size_t MiB = 1024 * 1024;
constexpr size_t WS_CTL = 0;
constexpr size_t CTL_BYTES = 65536;
constexpr size_t CTL_CNT_OFF = 16384;
constexpr size_t WS_MOD = 65536;
constexpr size_t WS_WIN = 1 * MiB;
constexpr size_t WS_WOUT = 9 * MiB;
constexpr size_t WS_WPOOL = 11 * MiB;
constexpr size_t WS_WG0 = 12 * MiB;
constexpr size_t WS_WU0 = 28 * MiB;
constexpr size_t WS_WD0 = 44 * MiB;
constexpr size_t WS_U = 60 * MiB;
constexpr size_t WS_PROJ = 100 * MiB;
constexpr size_t WS_WG1 = WS_PROJ;
constexpr size_t WS_WU1 = WS_PROJ + 16 * MiB;
constexpr size_t WS_WD1 = WS_PROJ + 32 * MiB;
constexpr size_t WS_HBUF = WS_PROJ + 48 * MiB;
constexpr size_t WS_HL = 230 * MiB;
constexpr size_t WS_HS = 262 * MiB;
constexpr size_t WS_HD = 294 * MiB;
constexpr size_t WS_U2S = WS_HL;
constexpr size_t WS_LIST = 295 * MiB;
constexpr size_t WS_WL = 295 * MiB + 128 * 1024;
constexpr size_t WS_TOKINFO = 295 * MiB + 512 * 1024;
constexpr size_t WS_BLKCNT = 296 * MiB;
constexpr size_t WS_END = 297 * MiB;

__device__ __forceinline__ unsigned f2bf(float f) { return (unsigned)__builtin_bit_cast(unsigned short, (__bf16)f); }
__device__ __forceinline__ float bf2f(unsigned b) { return __uint_as_float(b << 16); }
__device__ __forceinline__ unsigned pk2(float lo, float hi) { bf16x2_t v; v[0] = (__bf16)lo; v[1] = (__bf16)hi; return __builtin_bit_cast(unsigned, v); }
__device__ __forceinline__ float bflo(unsigned w) { return __uint_as_float(w << 16); }
__device__ __forceinline__ float bfhi(unsigned w) { return __uint_as_float(w & 0xffff0000u); }
__device__ __forceinline__ float wave_sum(float v) {
#pragma unroll
    for (int o = 1; o < 64; o <<= 1) v += __shfl_xor(v, o);
    return v;
}
__device__ __forceinline__ int tid_opaque() { int t = threadIdx.x; asm volatile("" : "+v"(t)); return t; }
__device__ __forceinline__ float sigmoidf_(float x) { return 1.0f / (1.0f + __expf(-x)); }
__device__ __forceinline__ float siluf_(float x) { return x / (1.0f + __expf(-x)); }
__device__ __forceinline__ float silu_fast(float x) { return x * __builtin_amdgcn_rcpf(1.0f + __builtin_amdgcn_exp2f(-1.4426950408889634f * x)); }
__device__ __forceinline__ float dot2bf(unsigned a, unsigned b, float acc) {
    return __builtin_amdgcn_fdot2_f32_bf16(__builtin_bit_cast(bf16x2_t, a), __builtin_bit_cast(bf16x2_t, b), acc, false);
}

#define XB_TMO      128
#define XB_XCNT(j)  (256  + 64 * (j))
#define XB_XSUB(j)  (1280 + 64 * (j))
#define XB_XGEN(j)  (2304 + 64 * (j))
#define XB_TOP      3328
#define XB_TOPGEN   3392
#define XCD_BAR_WORDS 3456
#define XB_SPIN_CAP (1u << 22)
__device__ __forceinline__ unsigned xb_ld(unsigned* p)              { return __hip_atomic_load(p, __ATOMIC_RELAXED, __HIP_MEMORY_SCOPE_AGENT); }
__device__ __forceinline__ unsigned xb_add(unsigned* p, unsigned v) { return __hip_atomic_fetch_add(p, v, __ATOMIC_RELAXED, __HIP_MEMORY_SCOPE_AGENT); }
__device__ __forceinline__ unsigned xb_xcc_id() { return (unsigned)__builtin_amdgcn_s_getreg((3 << 11) | 20) & 0xFu; }
#define XB_SPIN(cond, bar) do { unsigned _sp = 0; while (cond) { \
    if ((++_sp & 255u) == 0u) { if (xb_ld(&(bar)[XB_TMO])) break; if (_sp > XB_SPIN_CAP) { atomicAdd(&(bar)[XB_TMO], 1u); break; } } } } while (0)
struct XcdBarrier { unsigned* bar; unsigned x; volatile LAS unsigned* st; };
__device__ __forceinline__ XcdBarrier xcd_barrier_post(unsigned* bar, volatile LAS unsigned* st) {
    XcdBarrier b; b.bar = bar; b.x = xb_xcc_id(); b.st = st;
    if (threadIdx.x == 0) (void)xb_add(&bar[XB_XCNT(b.x)], 1u);
    return b;
}
__device__ __forceinline__ void xcd_barrier_complete(unsigned* bar, unsigned x, unsigned& nloc, unsigned& nx) {
    const unsigned G = gridDim.x * gridDim.y * gridDim.z;
    unsigned sum, cnt, mine, sp = 0u;
    for (;;) {
        sum = 0u; cnt = 0u; mine = 0u;
#pragma unroll
        for (unsigned j = 0; j < 16; ++j) { const unsigned c = xb_ld(&bar[XB_XCNT(j)]); sum += c; cnt += (c > 0u) ? 1u : 0u; mine = (j == x) ? c : mine; }
        if (sum == G) break;
        __builtin_amdgcn_s_sleep(1);
        if ((++sp & 255u) == 0u) { if (xb_ld(&bar[XB_TMO])) break; if (sp > XB_SPIN_CAP) { atomicAdd(&bar[XB_TMO], 1u); break; } }
    }
    nloc = mine > 0u ? mine : 1u; nx = cnt > 0u ? cnt : 1u;
}
__device__ __forceinline__ void xcd_barrier(const XcdBarrier& b) {
    asm volatile("s_waitcnt vmcnt(0)" ::: "memory");
    __syncthreads();
    if (threadIdx.x == 0) {
        unsigned* bar = b.bar;
        __builtin_amdgcn_s_waitcnt(0);
        unsigned nloc = b.st[0], nx = b.st[1];
        if (nloc == 0u) { xcd_barrier_complete(bar, b.x, nloc, nx); b.st[0] = nloc; b.st[1] = nx; }
        const unsigned old = xb_add(&bar[XB_XSUB(b.x)], 1u);
        const unsigned gen = old / nloc;
        if (old + 1u == (gen + 1u) * nloc) {
            __builtin_amdgcn_fence(__ATOMIC_RELEASE, "agent");
            asm volatile("s_waitcnt vmcnt(0)" ::: "memory");
            const unsigned og = xb_add(&bar[XB_TOP], 1u);
            const unsigned tg = og / nx;
            if (og + 1u == (tg + 1u) * nx) xb_add(&bar[XB_TOPGEN], 1u);
            else XB_SPIN(xb_ld(&bar[XB_TOPGEN]) == tg, bar);
            __builtin_amdgcn_fence(__ATOMIC_ACQUIRE, "agent");
            xb_add(&bar[XB_XGEN(b.x)], 1u);
            asm volatile("s_waitcnt vmcnt(0)" ::: "memory");
        } else {
            XB_SPIN(xb_ld(&bar[XB_XGEN(b.x)]) == gen, bar);
            __builtin_amdgcn_fence(__ATOMIC_ACQUIRE, "agent");
            asm volatile("s_waitcnt vmcnt(0)" ::: "memory");
        }
    }
    __syncthreads();
}

struct Params {
    const float *x, *c, *ctx, *c_ctx, *w_mod, *b_mod, *norm1_g, *norm2_g, *w_in, *w_out, *lb_logits, *a_norm_g, *rpb,
                *w_pool, *pool_scale, *w_router, *b_router, *w_gate, *w_up, *w_down, *final_g;
    float* out; unsigned char* ws; int ph_lo, ph_hi;
};

typedef const __attribute__((address_space(4))) Params* PP;
__device__ __forceinline__ PP params_here() {
    unsigned long long v = (unsigned long long)__builtin_amdgcn_kernarg_segment_ptr();
    asm volatile("" : "+s"(v));
    return (PP)v;
}
__device__ __forceinline__ void transpose_item(const float* W, int K, int N, bf16_t* WT, float* scr, int item, int lane) {
    const int nblk = N / 64, kb = item / nblk, nb = item % nblk, k0 = 64 * kb, n0 = 64 * nb;
    g8::f32x4 tv[16];
#pragma unroll
    for (int i = 0; i < 16; ++i) tv[i] = __builtin_nontemporal_load((const g8::f32x4*)(W + (size_t)(k0 + 4 * i + (lane >> 4)) * N + n0) + (lane & 15));
#pragma unroll
    for (int i = 0; i < 16; ++i) {
        float* s = scr + (4 * i + (lane >> 4)) * 65 + 4 * (lane & 15);
        s[0] = tv[i][0]; s[1] = tv[i][1]; s[2] = tv[i][2]; s[3] = tv[i][3];
    }
    asm volatile("s_waitcnt lgkmcnt(0)" ::: "memory");
    const int c = lane & 7;
#pragma unroll
    for (int j = 0; j < 8; ++j) {
        const int n = (lane >> 3) + 8 * j; const float* s = scr + (8 * c) * 65 + n;
        uint4 o; o.x = pk2(s[0 * 65], s[1 * 65]); o.y = pk2(s[2 * 65], s[3 * 65]); o.z = pk2(s[4 * 65], s[5 * 65]); o.w = pk2(s[6 * 65], s[7 * 65]);
        *(uint4*)(WT + (size_t)(n0 + n) * K + k0 + 8 * c) = o;
    }
    asm volatile("s_waitcnt lgkmcnt(0)" ::: "memory");
}
__device__ __forceinline__ void convert_expert_item(PP p, int layer, bf16_t* WG, bf16_t* WU, bf16_t* WD, float* scr, int r, int lane) {
    const int mi = r >> 7, item = r & 127, mat = mi >> 4, e = mi & 15;
    const size_t eoff = (size_t)(layer * 16 + e) * 1024 * 512;
    if (mat == 0) transpose_item(p->w_gate + eoff, 1024, 512, WG + (size_t)e * 512 * 1024, scr, item, lane);
    else if (mat == 1) transpose_item(p->w_up + eoff, 1024, 512, WU + (size_t)e * 512 * 1024, scr, item, lane);
    else transpose_item(p->w_down + eoff, 512, 1024, WD + (size_t)e * 1024 * 512, scr, item, lane);
}
__device__ __forceinline__ void phase_prep(PP p, unsigned char* smem) {
    const int t = tid_opaque(), lane = t & 63, w = t >> 6;
    float* modv = (float*)(p->ws + WS_MOD);
    {
        float* sc = (float*)smem; float* scc = sc + 1024; float* red = scc + 1024;
        for (int i = t; i < 1024; i += NTHREADS) { sc[i] = siluf_(p->c[i]); scc[i] = siluf_(p->c_ctx[i]); }
        __syncthreads();
        for (int u = blockIdx.x; u < 192; u += gridDim.x) {
            const int which = u / 96, col = (u % 96) * 64 + lane;
            const float* W = p->w_mod + (size_t)which * 1024 * 6144 + col;
            float a1 = 0.f, a2 = 0.f;
#pragma unroll 8
            for (int k = 128 * w; k < 128 * w + 128; ++k) { const float wv = W[(size_t)k * 6144]; a1 += sc[k] * wv; a2 += scc[k] * wv; }
            red[(w * 2 + 0) * 64 + lane] = a1; red[(w * 2 + 1) * 64 + lane] = a2;
            __syncthreads();
            if (t < 128) {
                const int sel = t >> 6, l = t & 63; float s = 0.f;
#pragma unroll
                for (int ww = 0; ww < 8; ++ww) s += red[(ww * 2 + sel) * 64 + l];
                const int cc = (u % 96) * 64 + l;
                s += p->b_mod[which * 6144 + cc];
                if (which == 0) modv[sel * 6144 + cc] = s; else if (sel == 0) modv[2 * 6144 + cc] = s;
            }
            __syncthreads();
        }
    }
    float* scr = (float*)smem + w * (64 * 65);
    const int gw = blockIdx.x * 8 + w, NGW = gridDim.x * 8;
    constexpr int I_IN = 16 * 64, I_OUT = 16 * 16, I_POOL = 4 * 16;
    for (int it = gw; it < I_IN + I_OUT + I_POOL; it += NGW) {
        int r = it;
        if (r < I_IN) { transpose_item(p->w_in, 1024, 4096, (bf16_t*)(p->ws + WS_WIN), scr, r, lane); continue; } r -= I_IN;
        if (r < I_OUT) { transpose_item(p->w_out, 1024, 1024, (bf16_t*)(p->ws + WS_WOUT), scr, r, lane); continue; } r -= I_OUT;
        { const int g = r >> 4; transpose_item(p->w_pool + (size_t)g * 65536, 256, 256, (bf16_t*)(p->ws + WS_WPOOL) + (size_t)g * 65536, scr, r & 15, lane); }
    }
}

__device__ __forceinline__ void norm_mod_rows4(const float* const (&xrow)[4], const float* g, const float* const (&shift)[4], const float* const (&scale)[4], bf16_t* const (&orow)[4], int lane) {
    float4 v[4][4]; float s[4];
#pragma unroll
    for (int q = 0; q < 4; ++q)
#pragma unroll
        for (int j = 0; j < 4; ++j) v[q][j] = ((const float4*)xrow[q])[lane + 64 * j];
#pragma unroll
    for (int q = 0; q < 4; ++q) { s[q] = 0.f;
#pragma unroll
        for (int j = 0; j < 4; ++j) s[q] += (v[q][j].x * v[q][j].x + v[q][j].y * v[q][j].y) + (v[q][j].z * v[q][j].z + v[q][j].w * v[q][j].w); }
#pragma unroll
    for (int m = 1; m < 64; m <<= 1) {
#pragma unroll
        for (int q = 0; q < 4; ++q) s[q] += __shfl_xor(s[q], m);
    }
#pragma unroll
    for (int q = 0; q < 4; ++q) {
        const float rstd = rsqrtf(s[q] * (1.0f / D) + EPS);
#pragma unroll
        for (int j = 0; j < 4; ++j) {
            const int c4 = lane + 64 * j;
            const float4 gg = ((const float4*)g)[c4], sh = ((const float4*)shift[q])[c4], sc = ((const float4*)scale[q])[c4];
            const float a = v[q][j].x * rstd * gg.x * (1.f + sc.x) + sh.x, b = v[q][j].y * rstd * gg.y * (1.f + sc.y) + sh.y;
            const float c = v[q][j].z * rstd * gg.z * (1.f + sc.z) + sh.z, d = v[q][j].w * rstd * gg.w * (1.f + sc.w) + sh.w;
            uint2 o; o.x = pk2(a, b); o.y = pk2(c, d);
            ((uint2*)orow[q])[c4] = o;
        }
    }
}
__device__ __forceinline__ void phase_norm0(PP p) {
    const int t_ = tid_opaque(); const int lane = t_ & 63, gw = blockIdx.x * 8 + (t_ >> 6), NGW = gridDim.x * 8;
    const float* modv = (const float*)(p->ws + WS_MOD);
    bf16_t* U = (bf16_t*)(p->ws + WS_U);
    for (int r0 = gw * 4; r0 < NTOK; r0 += NGW * 4) {
        const float* xr[4]; const float* shp[4]; const float* scp[4]; bf16_t* orow[4];
#pragma unroll
        for (int q = 0; q < 4; ++q) {
            const int r = r0 + q;
            const bool isc = r < CTXL;
            xr[q] = isc ? p->ctx + (size_t)r * D : p->x + (size_t)(r - CTXL) * D;
            shp[q] = modv + (isc ? 6144 : 0); scp[q] = modv + (isc ? 6144 : 0) + 1024;
            orow[q] = U + (size_t)r * D;
        }
        norm_mod_rows4(xr, p->norm1_g, shp, scp, orow, lane);
    }
}
__device__ __forceinline__ void phase_final(PP p) {
    const int t_ = tid_opaque(); const int lane = t_ & 63, gw = blockIdx.x * 8 + (t_ >> 6), NGW = gridDim.x * 8;
    for (int r0 = gw * 4; r0 < SEQ; r0 += NGW * 4) {
        float4 v[4][4]; float s[4];
#pragma unroll
        for (int q = 0; q < 4; ++q)
#pragma unroll
            for (int j = 0; j < 4; ++j) v[q][j] = ((const float4*)(p->out + (size_t)(r0 + q) * D))[lane + 64 * j];
#pragma unroll
        for (int q = 0; q < 4; ++q) { s[q] = 0.f;
#pragma unroll
            for (int j = 0; j < 4; ++j) s[q] += (v[q][j].x * v[q][j].x + v[q][j].y * v[q][j].y) + (v[q][j].z * v[q][j].z + v[q][j].w * v[q][j].w); }
#pragma unroll
        for (int m = 1; m < 64; m <<= 1) {
#pragma unroll
            for (int q = 0; q < 4; ++q) s[q] += __shfl_xor(s[q], m);
        }
#pragma unroll
        for (int q = 0; q < 4; ++q) {
            const float rstd = rsqrtf(s[q] * (1.0f / D) + EPS);
#pragma unroll
            for (int j = 0; j < 4; ++j) {
                const float4 gg = ((const float4*)p->final_g)[lane + 64 * j];
                float4 o; o.x = v[q][j].x * rstd * gg.x; o.y = v[q][j].y * rstd * gg.y; o.z = v[q][j].z * rstd * gg.z; o.w = v[q][j].w * rstd * gg.w;
                ((float4*)(p->out + (size_t)(r0 + q) * D))[lane + 64 * j] = o;
            }
        }
    }
}
__device__ __forceinline__ void phase_normpool(PP p, unsigned char* smem) {
    const int t = tid_opaque(), lane = t & 63, w = t >> 6;
    const float* modv = (const float*)(p->ws + WS_MOD) + 2 * 6144;
    const float* g = p->norm1_g + D; const float* sh = modv; const float* scl = modv + 1024;
    bf16_t* PA = (bf16_t*)(p->ws + WS_HL);
    for (int hf = 0; hf < 2; ++hf) {
        const int T0 = blockIdx.x * 64 + 32 * hf, R0 = T0 - 8;
        __syncthreads();
#pragma unroll
        for (int bt = 0; bt < 2; ++bt) {
            float4 v[3][4];
#pragma unroll
            for (int q = 0; q < 3; ++q) {
                const int tok = min(max(R0 + w * 6 + bt * 3 + q, 0), SEQ - 1);
#pragma unroll
                for (int j = 0; j < 4; ++j) v[q][j] = ((const float4*)(p->out + (size_t)tok * D))[lane + 64 * j];
            }
#pragma unroll
            for (int q = 0; q < 3; ++q) {
                float s = 0.f;
#pragma unroll
                for (int j = 0; j < 4; ++j) s += (v[q][j].x * v[q][j].x + v[q][j].y * v[q][j].y) + (v[q][j].z * v[q][j].z + v[q][j].w * v[q][j].w);
                const float rstd = rsqrtf(wave_sum(s) * (1.0f / D) + EPS);
                bf16_t* lrow = (bf16_t*)smem + (w * 6 + bt * 3 + q) * D;
#pragma unroll
                for (int j = 0; j < 4; ++j) {
                    const int c4 = lane + 64 * j;
                    const float4 gg = ((const float4*)g)[c4], s4 = ((const float4*)sh)[c4], c4v = ((const float4*)scl)[c4];
                    uint2 o;
                    o.x = pk2(v[q][j].x * rstd * gg.x * (1.f + c4v.x) + s4.x, v[q][j].y * rstd * gg.y * (1.f + c4v.y) + s4.y);
                    o.y = pk2(v[q][j].z * rstd * gg.z * (1.f + c4v.z) + s4.z, v[q][j].w * rstd * gg.w * (1.f + c4v.w) + s4.w);
                    ((uint2*)lrow)[c4] = o;
                }
            }
        }
        __syncthreads();
        {
            const int c8 = t & 127, run = t >> 7, gq = c8 >> 5, half = 1 << gq;
            const bf16_t* base = (const bf16_t*)smem + 8 * c8;
            const int tok0 = T0 + 8 * run;
            float s[8];
#pragma unroll
            for (int i = 0; i < 8; ++i) s[i] = 0.f;
            int lo = max(tok0 - half, 0), hi = min(tok0 + half, SEQ);
            for (int r = lo; r < hi; ++r) {
                const uint4 vv = *(const uint4*)(base + (r - R0) * D);
                s[0] += bflo(vv.x); s[1] += bfhi(vv.x); s[2] += bflo(vv.y); s[3] += bfhi(vv.y); s[4] += bflo(vv.z); s[5] += bfhi(vv.z); s[6] += bflo(vv.w); s[7] += bfhi(vv.w);
            }
#pragma unroll
            for (int q = 0; q < 8; ++q) {
                const int tok = tok0 + q;
                if (q > 0) {
                    const int nlo = max(tok - half, 0), nhi = min(tok + half, SEQ);
                    if (nhi > hi) { const uint4 vv = *(const uint4*)(base + (hi - R0) * D);
                        s[0] += bflo(vv.x); s[1] += bfhi(vv.x); s[2] += bflo(vv.y); s[3] += bfhi(vv.y); s[4] += bflo(vv.z); s[5] += bfhi(vv.z); s[6] += bflo(vv.w); s[7] += bfhi(vv.w); }
                    if (nlo > lo) { const uint4 vv = *(const uint4*)(base + (lo - R0) * D);
                        s[0] -= bflo(vv.x); s[1] -= bfhi(vv.x); s[2] -= bflo(vv.y); s[3] -= bfhi(vv.y); s[4] -= bflo(vv.z); s[5] -= bfhi(vv.z); s[6] -= bflo(vv.w); s[7] -= bfhi(vv.w); }
                    lo = nlo; hi = nhi;
                }
                const float ic = 1.0f / (float)(hi - lo);
                const uint4 me = *(const uint4*)(base + (tok - R0) * D);
                uint4 o;
                o.x = pk2(s[0] * ic - bflo(me.x), s[1] * ic - bfhi(me.x)); o.y = pk2(s[2] * ic - bflo(me.y), s[3] * ic - bfhi(me.y));
                o.z = pk2(s[4] * ic - bflo(me.z), s[5] * ic - bfhi(me.z)); o.w = pk2(s[6] * ic - bflo(me.w), s[7] * ic - bfhi(me.w));
                *(uint4*)(PA + (size_t)tok * D + 8 * c8) = o;
            }
        }
    }
}

namespace g8 {
constexpr int BM = 256, BK = 64, HALF = 128, HTB = HALF * BK * 2, STAGE_BYTES = 8 * HTB, NXCD = 8, WGM = 8;
__device__ __forceinline__ int lds_byte(int r, int c) { const int st = (r >> 4) * 2 + (c >> 5), rr = r & 15, cc = c & 31, ob = rr * 64 + cc * 2; return st * 1024 + (ob ^ (((ob >> 9) & 1) << 5)); }
__device__ __forceinline__ void stage_rc(int b, int& R, int& C) { const int st = b / 1024, sb = b % 1024, swz = sb ^ (((sb >> 9) & 1) << 5); R = (st >> 1) * 16 + swz / 64; C = (st & 1) * 32 + (swz % 64) / 2; }
__device__ __forceinline__ int perm32(int rho) { const int n = rho >> 4, i = rho & 15; return 8 * (i >> 2) + 4 * n + (i & 3); }
__device__ __forceinline__ unsigned cvt_pk_bf16(float lo, float hi) { return pk2(lo, hi); }

struct Unit { unsigned a0, a1, b0, b1; int bd; int pm, pn, x0, x1; };
__device__ __forceinline__ bool tile_of(int i, int G, int c, int nM, int nN, int& pm, int& pn) {
    const int nwg = nM * nN; const long L = (long)i * G + c; if (L >= nwg) return false;
    int wgid = (int)L; { const int q = nwg / NXCD, r = nwg % NXCD, xcd = wgid % NXCD, off = wgid / NXCD; wgid = (xcd < r ? xcd * (q + 1) : r * (q + 1) + (xcd - r) * q) + off; }
    const int nig = WGM * nN, gid = wgid / nig, fm = gid * WGM, gsz = (nM - fm) < WGM ? (nM - fm) : WGM;
    pm = fm + ((wgid % nig) % gsz); pn = (wgid % nig) / gsz; return true;
}
template <class Epi, class Sched>
__device__ __forceinline__ void gemm_phase(LAS unsigned char* lds, const char* base, const int K, const int lda, const int ldb, const int tsplit, const Sched& S, const Epi& E) {
    const int tid = tid_opaque(), wid = __builtin_amdgcn_readfirstlane(tid >> 6), lane = tid & 63, wr = wid >> 2, wc = wid & 3, fr = lane & 15, fq = lane >> 4;
    const int nt = K / BK;
    unsigned voffA[2], voffB[2];
#pragma unroll
    for (int i = 0; i < 2; ++i) { int R, C; stage_rc(tid * 16 + i * 8192, R, C); const int Rb = Epi::PERM ? ((R & ~31) + perm32(R & 31)) : R;
        voffA[i] = (unsigned)(R * lda + C) * 2u; voffB[i] = (unsigned)(Rb * ldb + C) * 2u; }
    constexpr unsigned kstep = BK * 2;
    const unsigned ldsw = (unsigned)wid * 1024u;
    const int aoff = lds_byte(wr * 64 + fr, fq * 8), boff = lds_byte(wc * 32 + fr, fq * 8);
#define G8_SA(b, h) (((b) * 2 + (h)) * HTB)
#define G8_SB(b, h) ((4 + (b) * 2 + (h)) * HTB)
#define G8_STAGE(bufoff, goff, voff) do { _Pragma("unroll") for (int _i = 0; _i < 2; ++_i) \
        __builtin_amdgcn_global_load_lds((const unsigned*)(base + (size_t)((voff)[_i] + (unsigned)(goff))), (LAS unsigned*)(lds + (bufoff) + ldsw + _i * 8192), 16, 0, 0); } while (0)
#define G8_LDA(dst, b, h) do { _Pragma("unroll") for (int m = 0; m < 4; ++m) _Pragma("unroll") for (int k = 0; k < 2; ++k) dst[m][k] = *(const LAS bf16x8*)(lds + G8_SA(b, h) + aoff + m * 2048 + k * 1024); } while (0)
#define G8_LDB(dst, b, h) do { _Pragma("unroll") for (int n = 0; n < 2; ++n) _Pragma("unroll") for (int k = 0; k < 2; ++k) dst[n][k] = *(const LAS bf16x8*)(lds + G8_SB(b, h) + boff + n * 2048 + k * 1024); } while (0)
#define G8_MMA(ai, bj, At, Bt) do { __builtin_amdgcn_s_setprio(1); _Pragma("unroll") for (int m = 0; m < 4; ++m) _Pragma("unroll") for (int n = 0; n < 2; ++n) _Pragma("unroll") for (int k = 0; k < 2; ++k) \
        acc[ai][bj][m][n] = __builtin_amdgcn_mfma_f32_16x16x32_bf16(Bt[n][k], At[m][k], acc[ai][bj][m][n], 0, 0, 0); __builtin_amdgcn_s_setprio(0); } while (0)
#define G8_WAIT_V(n) asm volatile("s_waitcnt vmcnt(" #n ")" ::: "memory")
#define G8_WAIT_L(n) asm volatile("s_waitcnt lgkmcnt(" #n ")" ::: "memory")
#define G8_BAR __builtin_amdgcn_s_barrier()
#define G8_SCHED __builtin_amdgcn_sched_barrier(0)
#define G8_BK(u, h, tt) ((u).b##h + (unsigned)(tt) * kstep + (unsigned)(((tt) >= tsplit) ? (u).bd : 0))
#define G8_P(off) ((unsigned)(off))
    Unit cur, nxt; int ui = 0;
    if (!S.next(0, cur)) return;
    f32x4 acc[2][2][4][2];
#pragma unroll
    for (int a = 0; a < 2; ++a)
#pragma unroll
        for (int b = 0; b < 2; ++b)
#pragma unroll
            for (int m = 0; m < 4; ++m)
#pragma unroll
                for (int n = 0; n < 2; ++n) acc[a][b][m][n] = (f32x4){0.f, 0.f, 0.f, 0.f};
    bf16x8 At[4][2], B0[2][2], B1[2][2];
    asm volatile("s_waitcnt vmcnt(0) lgkmcnt(0)" ::: "memory");
    __syncthreads();
    G8_STAGE(G8_SB(0, 0), G8_P(G8_BK(cur, 0, 0)), voffB); G8_STAGE(G8_SB(0, 1), G8_P(G8_BK(cur, 1, 0)), voffB); G8_STAGE(G8_SA(0, 0), G8_P(cur.a0), voffA); G8_STAGE(G8_SA(0, 1), G8_P(cur.a1), voffA);
    if (wr == 1) G8_BAR;
    G8_WAIT_V(2); G8_BAR;
    G8_STAGE(G8_SB(1, 0), G8_P(G8_BK(cur, 0, 1)), voffB); G8_STAGE(G8_SA(1, 0), G8_P(cur.a0 + kstep), voffA); G8_STAGE(G8_SB(1, 1), G8_P(G8_BK(cur, 1, 1)), voffB);
    G8_WAIT_V(6); G8_BAR;
    for (;;) {
        const bool has_next = S.next(ui + 1, nxt);
        if (!has_next) nxt = cur;
        for (int t = 0; t < nt; t += 2) {
            const bool last = (t == nt - 2);
            const unsigned a1 = G8_P(cur.a1 + (unsigned)(t + 1) * kstep);
            const int t2 = last ? 0 : t + 2, t3 = t2 + 1;
            const unsigned a20 = G8_P((last ? nxt.a0 : cur.a0) + (unsigned)t2 * kstep), a21 = G8_P((last ? nxt.a1 : cur.a1) + (unsigned)t2 * kstep);
            const unsigned b20 = G8_P(last ? G8_BK(nxt, 0, t2) : G8_BK(cur, 0, t2)), b21 = G8_P(last ? G8_BK(nxt, 1, t2) : G8_BK(cur, 1, t2));
            const unsigned a30 = a20 + kstep;
            const unsigned b30 = G8_P(last ? G8_BK(nxt, 0, t3) : G8_BK(cur, 0, t3)), b31 = G8_P(last ? G8_BK(nxt, 1, t3) : G8_BK(cur, 1, t3));
            G8_LDB(B0, 0, 0); G8_LDB(B1, 0, 1); G8_SCHED; G8_LDA(At, 0, 0); G8_STAGE(G8_SA(1, 1), a1, voffA);
            G8_WAIT_V(8); G8_WAIT_L(0); G8_BAR; G8_MMA(0, 0, At, B0); G8_MMA(0, 1, At, B1); G8_BAR; G8_SCHED;
            G8_LDA(At, 0, 1); G8_STAGE(G8_SB(0, 0), b20, voffB); G8_STAGE(G8_SB(0, 1), b21, voffB); G8_STAGE(G8_SA(0, 0), a20, voffA);
            G8_WAIT_V(8); G8_WAIT_L(0); G8_BAR; G8_MMA(1, 0, At, B0); G8_MMA(1, 1, At, B1); G8_BAR; G8_SCHED;
            G8_LDB(B0, 1, 0); G8_LDB(B1, 1, 1); G8_SCHED; G8_LDA(At, 1, 0); G8_STAGE(G8_SA(0, 1), a21, voffA);
            G8_WAIT_V(8); G8_WAIT_L(0); G8_BAR; G8_MMA(0, 0, At, B0); G8_MMA(0, 1, At, B1); G8_BAR; G8_SCHED;
            G8_LDA(At, 1, 1); G8_STAGE(G8_SB(1, 0), b30, voffB); G8_STAGE(G8_SB(1, 1), b31, voffB); G8_STAGE(G8_SA(1, 0), a30, voffA);
            G8_WAIT_V(8); G8_WAIT_L(0); G8_BAR; G8_MMA(1, 0, At, B0); G8_MMA(1, 1, At, B1); G8_BAR; G8_SCHED;
        }
        if (wr == 0) G8_BAR;
        E(acc, cur, wr, wc, fr, fq);
        if (!has_next) break;
#pragma unroll
        for (int a = 0; a < 2; ++a)
#pragma unroll
            for (int b = 0; b < 2; ++b)
#pragma unroll
                for (int m = 0; m < 4; ++m)
#pragma unroll
                    for (int n = 0; n < 2; ++n) acc[a][b][m][n] = (f32x4){0.f, 0.f, 0.f, 0.f};
        cur = nxt; ++ui;
        if (wr == 1) G8_BAR;
    }
    G8_WAIT_V(0);
    G8_BAR;
#undef G8_SA
#undef G8_SB
#undef G8_STAGE
#undef G8_LDA
#undef G8_LDB
#undef G8_MMA
#undef G8_WAIT_V
#undef G8_WAIT_L
#undef G8_BAR
#undef G8_SCHED
#undef G8_BK
#undef G8_P
}
struct DenseSched {
    unsigned A, B, a_tile, b_tile; int nM, nN, G, c;
    __device__ __forceinline__ bool next(int i, Unit& u) const {
        int pm, pn; if (!tile_of(i, G, c, nM, nN, pm, pn)) return false;
        u.pm = pm; u.pn = pn; u.x0 = 0; u.x1 = 0; u.bd = 0;
        u.a0 = A + (unsigned)pm * a_tile; u.a1 = u.a0 + a_tile / 2; u.b0 = B + (unsigned)pn * b_tile; u.b1 = u.b0 + b_tile / 2; return true;
    }
};
}

__device__ __forceinline__ void convert_experts_on_idle(PP p, unsigned char* smem, int layer, int first, int mat_lo, int mat_hi) {
    const int G = gridDim.x;
    if ((int)blockIdx.x < first || first >= G) return;
    const int t_ = tid_opaque(); const int lane = t_ & 63, w = t_ >> 6;
    __syncthreads();
    float* scr = (float*)smem + w * (64 * 65);
    bf16_t* WG = (bf16_t*)(p->ws + (layer ? WS_WG1 : WS_WG0)); bf16_t* WU = (bf16_t*)(p->ws + (layer ? WS_WU1 : WS_WU0)); bf16_t* WD = (bf16_t*)(p->ws + (layer ? WS_WD1 : WS_WD0));
    for (int it = mat_lo * 2048 + ((int)blockIdx.x - first) * 8 + w; it < mat_hi * 2048; it += (G - first) * 8) convert_expert_item(p, layer, WG, WU, WD, scr, it, lane);
    __syncthreads();
}
struct EpiProj {
    static constexpr bool PERM = true;
    bf16_t* O;
    __device__ __forceinline__ void operator()(const g8::f32x4 (&acc)[2][2][4][2], const g8::Unit& u, int wr, int wc, int fr, int fq) const {
        const int row0 = u.pm * 256 + wr * 64 + fr, col0 = u.pn * 256 + wc * 32 + 8 * fq;
#pragma unroll
        for (int ai = 0; ai < 2; ++ai)
#pragma unroll
            for (int m = 0; m < 4; ++m) { bf16_t* rowp = O + (size_t)(row0 + ai * 128 + m * 16) * INW + col0;
#pragma unroll
                for (int bj = 0; bj < 2; ++bj) { const g8::f32x4 v0 = acc[ai][bj][m][0], v1 = acc[ai][bj][m][1];
                    g8::u32x4 w; w.x = g8::cvt_pk_bf16(v0[0], v0[1]); w.y = g8::cvt_pk_bf16(v0[2], v0[3]); w.z = g8::cvt_pk_bf16(v1[0], v1[1]); w.w = g8::cvt_pk_bf16(v1[2], v1[3]);
                    *(g8::u32x4*)(rowp + bj * 128) = w; } }
    }
};
__device__ __forceinline__ void phase_inproj(PP p, unsigned char* smem) {
    g8::DenseSched S; S.A = (unsigned)WS_U; S.B = (unsigned)WS_WIN; S.a_tile = 256u * D * 2; S.b_tile = 256u * D * 2;
    S.nM = NTOK / 256; S.nN = INW / 256; S.G = gridDim.x; S.c = blockIdx.x;
    EpiProj E; E.O = (bf16_t*)(p->ws + WS_PROJ);
    g8::gemm_phase((LAS unsigned char*)smem, (const char*)p->ws, D, D, D, 1 << 30, S, E);
    { const int G = gridDim.x, nun = (NTOK / 256) * (INW / 256), rem = nun % G; convert_experts_on_idle(p, smem, 0, rem == 0 ? 0 : rem, 0, 2); }
}
struct EpiOut {
    static constexpr bool PERM = true;
    const float* x; const float* g1; float* out;
    __device__ __forceinline__ void operator()(const g8::f32x4 (&acc)[2][2][4][2], const g8::Unit& u, int wr, int wc, int fr, int fq) const {
        const int row0 = u.pm * 256 + wr * 64 + fr, col0 = u.pn * 256 + wc * 32 + 8 * fq;
        g8::f32x4 gv[2][2];
#pragma unroll
        for (int bj = 0; bj < 2; ++bj)
#pragma unroll
            for (int n = 0; n < 2; ++n) gv[bj][n] = *(const g8::f32x4*)(g1 + col0 + bj * 128 + n * 4);
#pragma unroll
        for (int ai = 0; ai < 2; ++ai)
#pragma unroll
            for (int m = 0; m < 4; ++m) { const size_t off = (size_t)(row0 + ai * 128 + m * 16) * D + col0;
#pragma unroll
                for (int bj = 0; bj < 2; ++bj)
#pragma unroll
                    for (int n = 0; n < 2; ++n) { const g8::f32x4 xv = *(const g8::f32x4*)(x + off + bj * 128 + n * 4);
                        *(g8::f32x4*)(out + off + bj * 128 + n * 4) = xv + gv[bj][n] * acc[ai][bj][m][n]; }
                asm volatile("" ::: "memory"); }
    }
};
__device__ __forceinline__ void phase_outproj(PP p, unsigned char* smem) {
    g8::DenseSched S; S.A = (unsigned)WS_U; S.B = (unsigned)WS_WOUT; S.a_tile = 256u * D * 2; S.b_tile = 256u * D * 2;
    S.nM = SEQ / 256; S.nN = D / 256; S.G = gridDim.x; S.c = blockIdx.x;
    EpiOut E; E.x = p->x; E.g1 = (const float*)(p->ws + WS_MOD) + 2 * 1024; E.out = p->out;
    g8::gemm_phase((LAS unsigned char*)smem, (const char*)p->ws, D, D, D, 1 << 30, S, E);
}
struct PoolSched {
    int G, c;
    __device__ __forceinline__ bool next(int i, g8::Unit& u) const {
        const int L = i * G + c; if (L >= 256) return false;
        const int pm = L >> 2, g = L & 3;
        u.pm = pm; u.pn = g; u.x0 = 0; u.x1 = 0; u.bd = 0;
        u.a0 = (unsigned)WS_HL + ((unsigned)pm * 256 * D + 256 * g) * 2; u.a1 = u.a0 + 128u * D * 2; u.b0 = (unsigned)WS_WPOOL + (unsigned)g * 65536 * 2; u.b1 = u.b0 + 128u * 256 * 2; return true;
    }
};
struct EpiPool {
    static constexpr bool PERM = true;
    const float* g1; const float* ps; float* out;
    __device__ __forceinline__ void operator()(const g8::f32x4 (&acc)[2][2][4][2], const g8::Unit& u, int wr, int wc, int fr, int fq) const {
        const int row0 = u.pm * 256 + wr * 64 + fr, col0 = u.pn * 256 + wc * 32 + 8 * fq;
        g8::f32x4 gv[2][2];
#pragma unroll
        for (int bj = 0; bj < 2; ++bj)
#pragma unroll
            for (int n = 0; n < 2; ++n) gv[bj][n] = *(const g8::f32x4*)(g1 + col0 + bj * 128 + n * 4) * *(const g8::f32x4*)(ps + col0 + bj * 128 + n * 4);
#pragma unroll
        for (int ai = 0; ai < 2; ++ai)
#pragma unroll
            for (int m = 0; m < 4; ++m) { const size_t off = (size_t)(row0 + ai * 128 + m * 16) * D + col0;
#pragma unroll
                for (int bj = 0; bj < 2; ++bj)
#pragma unroll
                    for (int n = 0; n < 2; ++n) { g8::f32x4* op = (g8::f32x4*)(out + off + bj * 128 + n * 4); const g8::f32x4 hv = *op;
                        *op = hv + gv[bj][n] * acc[ai][bj][m][n]; }
                asm volatile("" ::: "memory"); }
    }
};
__device__ __forceinline__ void phase_poolgemm(PP p, unsigned char* smem) {
    PoolSched S; S.G = gridDim.x; S.c = blockIdx.x;
    EpiPool E; E.g1 = (const float*)(p->ws + WS_MOD) + 2 * 6144 + 2 * 1024; E.ps = p->pool_scale; E.out = p->out;
    g8::gemm_phase((LAS unsigned char*)smem, (const char*)p->ws, 256, D, 256, 1 << 30, S, E);
}

__device__ __forceinline__ int scan_row(int d, int pos) { return d == 0 ? pos : (pos < CTXL ? (CTXL - 1 - pos) : (CTXL + SEQ - 1 - (pos - CTXL))); }
__device__ __forceinline__ float lb_of(PP p, int d, int kw) { return sigmoidf_(p->lb_logits[1024 + d * 512 + kw] - p->lb_logits[d * 512 + kw]); }

constexpr int HG_QT = 0;
constexpr int HG_KT = 17408;
constexpr int HG_QS = 34816;
constexpr int HG_KE = 52224;
constexpr int HG_VT = 70656;
constexpr int HG_ST = 89088;
constexpr int HG_SEG = 123904;
constexpr int HG_DV = 125952;
typedef float f32x4v __attribute__((ext_vector_type(4)));
struct GateRaw { unsigned f[16], v[16], q[16]; };
template <bool FULL>
__device__ __forceinline__ void hgrn_gates_load(PP p, int d, int h, int pos0, int t, GateRaw& R) {
    const int k = t & 127, qd = t >> 7;
    const bf16_t* PROJ = (const bf16_t*)(p->ws + WS_PROJ);
#pragma unroll
    for (int i = 0; i < 16; ++i) {
        const int row = scan_row(d, pos0 + 16 * qd + i);
        const bf16_t* pr = PROJ + (size_t)row * INW + 128 * h + k;
        R.f[i] = pr[512 + 512 * d]; R.v[i] = pr[1536];
        if (FULL) R.q[i] = pr[0]; else R.q[i] = 0u;
    }
}
__device__ __forceinline__ void gate_raw_pin(GateRaw& R) {
#define PIN16(a) asm volatile("" : "+v"(a[0]), "+v"(a[1]), "+v"(a[2]), "+v"(a[3]), "+v"(a[4]), "+v"(a[5]), "+v"(a[6]), "+v"(a[7]), "+v"(a[8]), "+v"(a[9]), "+v"(a[10]), "+v"(a[11]), "+v"(a[12]), "+v"(a[13]), "+v"(a[14]), "+v"(a[15]))
    PIN16(R.f); PIN16(R.v); PIN16(R.q);
#undef PIN16
}
template <bool FULL>
__device__ __forceinline__ float hgrn_gates_compute(unsigned char* smem, const GateRaw& R, float lbv, int t) {
    const int k = t & 127, qd = t >> 7;
    float* seg = (float*)(smem + HG_SEG); float* Dv = (float*)(smem + HG_DV);
    float a[16], kk[16];
    const float L2E = 1.4426950408889634f;
#pragma unroll
    for (int i = 0; i < 16; ++i) {
        const float sg = __builtin_amdgcn_rcpf(1.0f + __builtin_amdgcn_exp2f(-L2E * bf2f(R.f[i])));
        const float f = lbv + (1.f - lbv) * sg;
        a[i] = __builtin_amdgcn_logf(f); kk[i] = 1.f - f;
    }
#pragma unroll
    for (int i = 1; i < 16; ++i) a[i] += a[i - 1];
    seg[qd * 128 + k] = a[15];
    __syncthreads();
    const float s0 = seg[k], s1 = seg[128 + k], s2 = seg[256 + k], s3 = seg[384 + k];
    const float off = qd == 0 ? 0.f : qd == 1 ? s0 : qd == 2 ? (s0 + s1) : (s0 + s1 + s2);
    const float bref = s0 + s1, btot = (s0 + s1) + (s2 + s3);
    const float dtot = __builtin_amdgcn_exp2f(btot);
    if (qd == 0) Dv[k] = dtot;
    unsigned kew[8], vw[8];
    bf16_t* QT = (bf16_t*)(smem + HG_QT); bf16_t* KT = (bf16_t*)(smem + HG_KT); bf16_t* QS = (bf16_t*)(smem + HG_QS);
    const float qscale = 0.08838834764831845f;
#pragma unroll
    for (int i = 0; i < 16; i += 2) {
        const float b0 = off + a[i], b1 = off + a[i + 1];
        kew[i >> 1] = g8::cvt_pk_bf16(kk[i] * __builtin_amdgcn_exp2f(btot - b0), kk[i + 1] * __builtin_amdgcn_exp2f(btot - b1));
        vw[i >> 1] = R.v[i] | (R.v[i + 1] << 16);
        if (FULL) {
            const float e0 = fminf(fmaxf(b0 - bref, -110.f), 110.f), e1 = fminf(fmaxf(b1 - bref, -110.f), 110.f);
            const float E0 = __builtin_amdgcn_exp2f(e0), E1 = __builtin_amdgcn_exp2f(e1);
            const float q0 = bf2f(R.q[i]) * qscale, q1 = bf2f(R.q[i + 1]) * qscale;
            const unsigned wq = g8::cvt_pk_bf16(q0 * E0, q1 * E1);
            const unsigned wk = g8::cvt_pk_bf16(kk[i] * __builtin_amdgcn_rcpf(E0), kk[i + 1] * __builtin_amdgcn_rcpf(E1));
            const unsigned ws_ = g8::cvt_pk_bf16(q0 * __builtin_amdgcn_exp2f(b0), q1 * __builtin_amdgcn_exp2f(b1));
            const int r0 = (16 * qd + i) * 136 + k, r1 = r0 + 136;
            QT[r0] = (bf16_t)(wq & 0xffffu); QT[r1] = (bf16_t)(wq >> 16);
            KT[r0] = (bf16_t)(wk & 0xffffu); KT[r1] = (bf16_t)(wk >> 16);
            QS[r0] = (bf16_t)(ws_ & 0xffffu); QS[r1] = (bf16_t)(ws_ >> 16);
        }
    }
    uint4* ke = (uint4*)(smem + HG_KE + k * 144 + qd * 32); uint4* vt = (uint4*)(smem + HG_VT + k * 144 + qd * 32);
    ke[0] = make_uint4(kew[0], kew[1], kew[2], kew[3]); ke[1] = make_uint4(kew[4], kew[5], kew[6], kew[7]);
    vt[0] = make_uint4(vw[0], vw[1], vw[2], vw[3]); vt[1] = make_uint4(vw[4], vw[5], vw[6], vw[7]);
    return dtot;
}
__device__ __forceinline__ void hgrn_state_update(unsigned char* smem, f32x16 (&sacc)[2], int w, int lane) {
    const int r = lane & 31, hh = lane >> 5, vt = w & 3;
    const float* Dv = (const float*)(smem + HG_DV);
#pragma unroll
    for (int kt2 = 0; kt2 < 2; ++kt2) {
        const int kt = 2 * (w >> 2) + kt2;
#pragma unroll
        for (int g = 0; g < 4; ++g) {
            const f32x4v dv = *(const f32x4v*)(Dv + 32 * kt + 8 * g + 4 * hh);
            sacc[kt2][4 * g + 0] *= dv[0]; sacc[kt2][4 * g + 1] *= dv[1]; sacc[kt2][4 * g + 2] *= dv[2]; sacc[kt2][4 * g + 3] *= dv[3];
        }
        {
            bf16x8 ao[4], bo[4];
#pragma unroll
            for (int js = 0; js < 4; ++js) {
                ao[js] = *(const bf16x8*)(smem + HG_KE + (32 * kt + r) * 144 + (16 * js + 8 * hh) * 2);
                bo[js] = *(const bf16x8*)(smem + HG_VT + (32 * vt + r) * 144 + (16 * js + 8 * hh) * 2);
            }
            __builtin_amdgcn_sched_barrier(0);
#pragma unroll
            for (int js = 0; js < 4; ++js) sacc[kt2] = __builtin_amdgcn_mfma_f32_32x32x16_bf16(ao[js], bo[js], sacc[kt2], 0, 0, 0);
        }
    }
}
__device__ __forceinline__ void hgrn_passA_unit(PP p, unsigned char* smem, int u) {
    const int d = u >> 8, h = (u >> 6) & 3, c = u & 63;
    const int t = tid_opaque(), lane = t & 63, w = t >> 6;
    const float lbv = lb_of(p, d, 128 * h + (t & 127));
    f32x16 sacc[2];
#pragma unroll
    for (int i = 0; i < 16; ++i) { sacc[0][i] = 0.f; sacc[1][i] = 0.f; }
    float Dtot = 1.f;
    GateRaw R;
    hgrn_gates_load<false>(p, d, h, 256 * c, t, R);
    for (int sub = 0; sub < 4; ++sub) {
        gate_raw_pin(R);
        Dtot *= hgrn_gates_compute<false>(smem, R, lbv, t);
        if (sub < 3) hgrn_gates_load<false>(p, d, h, 256 * c + 64 * (sub + 1), t, R);
        __syncthreads();
        hgrn_state_update(smem, sacc, w, lane);
    }
    float* L = (float*)(p->ws + WS_HL) + (size_t)u * 16384;
    const int r = lane & 31, hh = lane >> 5, vt = w & 3;
#pragma unroll
    for (int kt2 = 0; kt2 < 2; ++kt2)
#pragma unroll
        for (int e = 0; e < 16; ++e) L[(32 * (2 * (w >> 2) + kt2) + (e & 3) + 8 * (e >> 2) + 4 * hh) * 128 + 32 * vt + r] = sacc[kt2][e];
    if (t < 128) ((float*)(p->ws + WS_HD))[(size_t)u * 128 + t] = Dtot;
    __syncthreads();
}
__device__ __forceinline__ void phase_hgrnB(PP p) {
    const float* __restrict__ L = (const float*)(p->ws + WS_HL); const float* __restrict__ Dd = (const float*)(p->ws + WS_HD); float* __restrict__ SST = (float*)(p->ws + WS_HS);
    const int t_ = tid_opaque();
    for (int e = blockIdx.x * NTHREADS + t_; e < 8 * 16384; e += gridDim.x * NTHREADS) {
        const int dh = e >> 14, kv = e & 16383, k = kv >> 7;
        float S = 0.f;
        for (int c0 = 0; c0 < 64; c0 += 16) {
            float lv[16], dv[16];
#pragma unroll
            for (int c = 0; c < 16; ++c) { const size_t ui = (size_t)dh * 64 + c0 + c; lv[c] = L[ui * 16384 + kv]; dv[c] = Dd[ui * 128 + k]; }
#pragma unroll
            for (int c = 0; c < 16; ++c) { const size_t ui = (size_t)dh * 64 + c0 + c; S = dv[c] * S + lv[c]; SST[ui * 16384 + kv] = S; }
        }
    }
}
__device__ __forceinline__ void hgrn_passC_unit(PP p, unsigned char* smem, int u) {
    const int h = u >> 6, jb = u & 63;
    const int t = tid_opaque(), lane = t & 63, w = t >> 6, r = lane & 31, hh = lane >> 5, vt = w & 3, it = w >> 2;
    const bf16_t* PROJ = (const bf16_t*)(p->ws + WS_PROJ);
    float* OSF = (float*)(p->ws + WS_HL) + ((size_t)h * SEQ + 256 * jb) * 128;
    float* OSB = p->out + ((size_t)h * SEQ + 256 * jb) * 128;
    const float lb0 = lb_of(p, 0, 128 * h + (t & 127)), lb1 = lb_of(p, 1, 128 * h + (t & 127));
    GateRaw R;
    hgrn_gates_load<true>(p, 0, h, 256 * (1 + jb), t, R);
    f32x16 sacc[2];
    for (int step = 0; step < 8; ++step) {
        const int d = step >> 2, sub = step & 3;
        const int cs = (d == 0) ? (1 + jb) : (64 - jb);
        if (sub == 0) {
            const float* S0 = (const float*)(p->ws + WS_HS) + ((size_t)(d * 4 + h) * 64 + (cs - 1)) * 16384;
#pragma unroll
            for (int kt2 = 0; kt2 < 2; ++kt2)
#pragma unroll
                for (int e = 0; e < 16; ++e) sacc[kt2][e] = S0[(32 * (2 * it + kt2) + (e & 3) + 8 * (e >> 2) + 4 * hh) * 128 + 32 * vt + r];
        }
#pragma unroll
        for (int kt2 = 0; kt2 < 2; ++kt2)
#pragma unroll
            for (int g = 0; g < 4; ++g) {
                uint2 o; o.x = g8::cvt_pk_bf16(sacc[kt2][4 * g + 0], sacc[kt2][4 * g + 1]); o.y = g8::cvt_pk_bf16(sacc[kt2][4 * g + 2], sacc[kt2][4 * g + 3]);
                *(uint2*)(smem + HG_ST + (32 * vt + r) * 272 + (32 * (2 * it + kt2) + 8 * g + 4 * hh) * 2) = o;
            }
        gate_raw_pin(R);
        (void)hgrn_gates_compute<true>(smem, R, d ? lb1 : lb0, t);
        if (step < 7) { const int d2 = (step + 1) >> 2, sub2 = (step + 1) & 3; hgrn_gates_load<true>(p, d2, h, 256 * (d2 == 0 ? (1 + jb) : (64 - jb)) + 64 * sub2, t, R); }
        __syncthreads();
        f32x16 o;
#pragma unroll
        for (int e = 0; e < 16; ++e) o[e] = 0.f;
#pragma unroll
        for (int jt = 0; jt < 2; ++jt) {
            if (jt <= it) {
                f32x16 sT;
#pragma unroll
                for (int e = 0; e < 16; ++e) sT[e] = 0.f;
                {
                    bf16x8 ao[8], bo[8];
#pragma unroll
                    for (int ks = 0; ks < 8; ++ks) {
                        ao[ks] = *(const bf16x8*)(smem + HG_KT + (32 * jt + r) * 272 + (16 * ks + 8 * hh) * 2);
                        bo[ks] = *(const bf16x8*)(smem + HG_QT + (32 * it + r) * 272 + (16 * ks + 8 * hh) * 2);
                    }
                    __builtin_amdgcn_sched_barrier(0);
#pragma unroll
                    for (int ks = 0; ks < 8; ++ks) sT = __builtin_amdgcn_mfma_f32_32x32x16_bf16(ao[ks], bo[ks], sT, 0, 0, 0);
                }
                if (jt == it) {
#pragma unroll
                    for (int e = 0; e < 16; ++e) { const int j = (e & 3) + 8 * (e >> 2) + 4 * hh; sT[e] = (j <= r) ? sT[e] : 0.f; }
                }
#pragma unroll
                for (int s = 0; s < 2; ++s) {
                    bf16x8 pa;
                    const unsigned w0 = g8::cvt_pk_bf16(sT[8 * s + 0], sT[8 * s + 1]), w1 = g8::cvt_pk_bf16(sT[8 * s + 2], sT[8 * s + 3]), w2 = g8::cvt_pk_bf16(sT[8 * s + 4], sT[8 * s + 5]), w3 = g8::cvt_pk_bf16(sT[8 * s + 6], sT[8 * s + 7]);
                    pa[0] = (short)(w0 & 0xffff); pa[1] = (short)(w0 >> 16); pa[2] = (short)(w1 & 0xffff); pa[3] = (short)(w1 >> 16);
                    pa[4] = (short)(w2 & 0xffff); pa[5] = (short)(w2 >> 16); pa[6] = (short)(w3 & 0xffff); pa[7] = (short)(w3 >> 16);
                    const uint2 v0 = *(const uint2*)(smem + HG_VT + (32 * vt + r) * 144 + (32 * jt + 16 * s + 4 * hh) * 2);
                    const uint2 v1 = *(const uint2*)(smem + HG_VT + (32 * vt + r) * 144 + (32 * jt + 16 * s + 8 + 4 * hh) * 2);
                    bf16x8 vb;
                    vb[0] = (short)(v0.x & 0xffff); vb[1] = (short)(v0.x >> 16); vb[2] = (short)(v0.y & 0xffff); vb[3] = (short)(v0.y >> 16);
                    vb[4] = (short)(v1.x & 0xffff); vb[5] = (short)(v1.x >> 16); vb[6] = (short)(v1.y & 0xffff); vb[7] = (short)(v1.y >> 16);
                    o = __builtin_amdgcn_mfma_f32_32x32x16_bf16(pa, vb, o, 0, 0, 0);
                }
            }
        }
        {
            bf16x8 ao[8], bo[8];
#pragma unroll
            for (int ks = 0; ks < 8; ++ks) {
                ao[ks] = *(const bf16x8*)(smem + HG_QS + (32 * it + r) * 272 + (16 * ks + 8 * hh) * 2);
                bo[ks] = *(const bf16x8*)(smem + HG_ST + (32 * vt + r) * 272 + (16 * ks + 8 * hh) * 2);
            }
            __builtin_amdgcn_sched_barrier(0);
#pragma unroll
            for (int ks = 0; ks < 8; ++ks) o = __builtin_amdgcn_mfma_f32_32x32x16_bf16(ao[ks], bo[ks], o, 0, 0, 0);
        }
        {
            float* OS = d ? OSB : OSF;
#pragma unroll
            for (int e = 0; e < 16; ++e) {
                const int pos = 64 * sub + 32 * it + (e & 3) + 8 * (e >> 2) + 4 * hh;
                const int tl = (d == 0) ? pos : (255 - pos);
                OS[tl * 128 + 32 * vt + r] = o[e];
            }
        }
        hgrn_state_update(smem, sacc, w, lane);
        __syncthreads();
    }
    __syncthreads();
    bf16_t* AB = (bf16_t*)(p->ws + WS_U);
    const float ng0 = p->a_norm_g[128 * h + lane], ng1 = p->a_norm_g[128 * h + 64 + lane];
    for (int tb = 0; tb < 4; ++tb) {
        float o0[8], o1[8], g0[8], g1[8];
#pragma unroll
        for (int q = 0; q < 8; ++q) {
            const int tl = w * 32 + tb * 8 + q;
            o0[q] = OSF[tl * 128 + lane] + OSB[tl * 128 + lane]; o1[q] = OSF[tl * 128 + 64 + lane] + OSB[tl * 128 + 64 + lane];
            const bf16_t* pr = PROJ + (size_t)(CTXL + 256 * jb + tl) * INW + 2048 + 128 * h;
            g0[q] = bf2f(pr[lane]); g1[q] = bf2f(pr[64 + lane]);
        }
        float ss[8];
#pragma unroll
        for (int q = 0; q < 8; ++q) ss[q] = o0[q] * o0[q] + o1[q] * o1[q];
#pragma unroll
        for (int m = 1; m < 64; m <<= 1) {
#pragma unroll
            for (int q = 0; q < 8; ++q) ss[q] += __shfl_xor(ss[q], m);
        }
#pragma unroll
        for (int q = 0; q < 8; ++q) {
            const int tok = 256 * jb + w * 32 + tb * 8 + q;
            const float rr = rsqrtf(ss[q] * (1.0f / 128.0f) + EPS);
            AB[(size_t)tok * D + 128 * h + lane] = (bf16_t)f2bf(o0[q] * rr * ng0 * silu_fast(g0[q]));
            AB[(size_t)tok * D + 128 * h + 64 + lane] = (bf16_t)f2bf(o1[q] * rr * ng1 * silu_fast(g1[q]));
        }
    }
    __syncthreads();
}

constexpr int AT_VW = 0;
constexpr int AT_VC = 73728;
constexpr int AT_BS = 106496;
constexpr int AT_MG = 0;
typedef unsigned short u16x4 __attribute__((ext_vector_type(4)));
#define AT_TRREAD4(a0, a1, b0, b1, addr) asm volatile("ds_read_b64_tr_b16 %0, %4\n\tds_read_b64_tr_b16 %1, %4 offset:1024\n\tds_read_b64_tr_b16 %2, %4 offset:64\n\tds_read_b64_tr_b16 %3, %4 offset:1088\n\ts_waitcnt lgkmcnt(0)" \
    : "=&v"(a0), "=&v"(a1), "=&v"(b0), "=&v"(b1) : "v"(addr) : "memory")
__device__ __forceinline__ void attn_unit(PP p, unsigned char* smem, int u) {
    const int h = u >> 7, bb = u & 127, rp = (bb & 7) * 16 + (bb >> 3), r0 = 2 * rp;
    const int t = tid_opaque(), lane = t & 63, w = __builtin_amdgcn_readfirstlane(t >> 6), qt = w & 3, part = w >> 2, ql = lane & 31, hh = lane >> 5;
    const bf16_t* PROJ = (const bf16_t*)(p->ws + WS_PROJ);
    float* bS = (float*)(smem + AT_BS);
    const int krb = min(max(r0 - 4, 0), 248);
    __syncthreads();
#pragma unroll
    for (int i = 0; i < 9; ++i) {
        const int e = t + 512 * i, key = e >> 3, piece = e & 7;
        const int tok = min(krb + (key >> 6), 255) * 64 + (key & 63);
        *(uint4*)(smem + AT_VW + key * 128 + piece * 16) = *(const uint4*)(PROJ + (size_t)(CTXL + tok) * INW + 3584 + 64 * h + 8 * piece);
    }
#pragma unroll
    for (int i = 0; i < 4; ++i) {
        const int e = t + 512 * i, key = e >> 3, piece = e & 7;
        *(uint4*)(smem + AT_VC + key * 128 + piece * 16) = *(const uint4*)(PROJ + (size_t)key * INW + 3584 + 64 * h + 8 * piece);
    }
    if (t < 465) bS[t] = p->rpb[h * 465 + t] * 1.4426950408889634f;
    const int qr = r0 + (ql >> 4), qcol = 16 * qt + (ql & 15);
    bf16x8 qf[4];
    {
        const bf16_t* qp = PROJ + (size_t)(CTXL + qr * 64 + qcol) * INW + 2560 + 64 * h + 8 * hh;
#pragma unroll
        for (int s = 0; s < 4; ++s) {
            const uint4 qv = *(const uint4*)(qp + 16 * s);
            const float qs_ = 0.125f * 1.4426950408889634f;
            const unsigned w0 = pk2(bflo(qv.x) * qs_, bfhi(qv.x) * qs_), w1 = pk2(bflo(qv.y) * qs_, bfhi(qv.y) * qs_);
            const unsigned w2 = pk2(bflo(qv.z) * qs_, bfhi(qv.z) * qs_), w3 = pk2(bflo(qv.w) * qs_, bfhi(qv.w) * qs_);
            qf[s][0] = (short)(w0 & 0xffff); qf[s][1] = (short)(w0 >> 16); qf[s][2] = (short)(w1 & 0xffff); qf[s][3] = (short)(w1 >> 16);
            qf[s][4] = (short)(w2 & 0xffff); qf[s][5] = (short)(w2 >> 16); qf[s][6] = (short)(w3 & 0xffff); qf[s][7] = (short)(w3 >> 16);
        }
    }
    const int kcs = min(max(16 * qt - 8, 0), 32);
    const int krq = min(max(qr - 4, 0), 248), kc0q = min(max(qcol - 8, 0), 48);
    unsigned cmask = 0u;
#pragma unroll
    for (int e = 0; e < 16; ++e) { const int kc = kcs + (e & 3) + 8 * (e >> 2) + 4 * hh; cmask |= ((unsigned)(kc - kc0q) < 16u) ? (1u << e) : 0u; }
    const int dcb = kcs + 4 * hh - qcol + 15;
    auto loadK = [&](int ti, uint4 (&kf)[4]) {
        int row;
        if (ti < 9) row = CTXL + min(krb + ti, 255) * 64 + kcs + ql; else row = 32 * (ti - 9) + ql;
        const bf16_t* kp = PROJ + (size_t)row * INW + 3072 + 64 * h + 8 * hh;
#pragma unroll
        for (int s = 0; s < 4; ++s) kf[s] = *(const uint4*)(kp + 16 * s);
    };
    const int tb = part ? 6 : 0, te = part ? 17 : 6;
    float mrun = -1e30f, lrun = 0.f;
    f32x16 oT[2];
#pragma unroll
    for (int e = 0; e < 16; ++e) { oT[0][e] = 0.f; oT[1][e] = 0.f; }
    auto scores = [&](int ti, const uint4 (&kf)[4], float (&sc)[16]) {
        f32x16 sT;
#pragma unroll
        for (int e = 0; e < 16; ++e) sT[e] = 0.f;
#pragma unroll
        for (int s = 0; s < 4; ++s) {
            bf16x8 ka;
            ka[0] = (short)(kf[s].x & 0xffff); ka[1] = (short)(kf[s].x >> 16); ka[2] = (short)(kf[s].y & 0xffff); ka[3] = (short)(kf[s].y >> 16);
            ka[4] = (short)(kf[s].z & 0xffff); ka[5] = (short)(kf[s].z >> 16); ka[6] = (short)(kf[s].w & 0xffff); ka[7] = (short)(kf[s].w >> 16);
            sT = __builtin_amdgcn_mfma_f32_32x32x16_bf16(ka, qf[s], sT, 0, 0, 0);
        }
        if (ti < 9) {
            const int kr = krb + ti;
            const bool rv = (kr >= krq) && (kr < krq + 8) && (kr < 256);
            const unsigned okm = rv ? cmask : 0u;
            const float* brow = bS + min(max((kr - qr + 7), 0), 14) * 31 + dcb;
            float bv[16];
#pragma unroll
            for (int e = 0; e < 16; ++e) bv[e] = brow[(e & 3) + 8 * (e >> 2)];
#pragma unroll
            for (int e = 0; e < 16; ++e) sc[e] = ((okm >> e) & 1u) ? (sT[e] + bv[e]) : -3e38f;
        } else if (ti < 17) {
#pragma unroll
            for (int e = 0; e < 16; ++e) sc[e] = sT[e];
        } else {
#pragma unroll
            for (int e = 0; e < 16; ++e) sc[e] = -3e38f;
        }
    };
    auto v_issue = [&](int ti, u16x4 (&vf)[8]) {
        const int tic = min(ti, 16);
        const int vbase = (tic < 9) ? (AT_VW + (tic * 64 + kcs) * 128) : (AT_VC + (32 * (tic - 9)) * 128);
        const unsigned va = (unsigned)(vbase + (4 * hh + ((lane & 15) >> 2)) * 128 + (16 * ((lane >> 4) & 1) + 4 * (lane & 3)) * 2);
        asm volatile("ds_read_b64_tr_b16 %0, %8\n\tds_read_b64_tr_b16 %1, %8 offset:1024\n\tds_read_b64_tr_b16 %2, %8 offset:64\n\tds_read_b64_tr_b16 %3, %8 offset:1088\n\t"
                     "ds_read_b64_tr_b16 %4, %8 offset:2048\n\tds_read_b64_tr_b16 %5, %8 offset:3072\n\tds_read_b64_tr_b16 %6, %8 offset:2112\n\tds_read_b64_tr_b16 %7, %8 offset:3136"
                     : "=&v"(vf[0]), "=&v"(vf[1]), "=&v"(vf[2]), "=&v"(vf[3]), "=&v"(vf[4]), "=&v"(vf[5]), "=&v"(vf[6]), "=&v"(vf[7]) : "v"(va) : "memory");
    };
    auto v_wait = [&](u16x4 (&va)[8], u16x4 (&vb)[8]) {
        asm volatile("s_waitcnt lgkmcnt(0)" : "+v"(va[0]), "+v"(va[1]), "+v"(va[2]), "+v"(va[3]), "+v"(va[4]), "+v"(va[5]), "+v"(va[6]), "+v"(va[7]),
                                               "+v"(vb[0]), "+v"(vb[1]), "+v"(vb[2]), "+v"(vb[3]), "+v"(vb[4]), "+v"(vb[5]), "+v"(vb[6]), "+v"(vb[7]) :: "memory");
    };
    auto pv_acc = [&](const u16x4 (&vf)[8], const float (&pv)[16]) {
#pragma unroll
        for (int s2 = 0; s2 < 2; ++s2) {
            const u16x4 a0 = vf[4 * s2 + 0], a1 = vf[4 * s2 + 1], b0 = vf[4 * s2 + 2], b1 = vf[4 * s2 + 3];
            bf16x8 va0, va1, pb;
            va0[0] = (short)a0[0]; va0[1] = (short)a0[1]; va0[2] = (short)a0[2]; va0[3] = (short)a0[3]; va0[4] = (short)a1[0]; va0[5] = (short)a1[1]; va0[6] = (short)a1[2]; va0[7] = (short)a1[3];
            va1[0] = (short)b0[0]; va1[1] = (short)b0[1]; va1[2] = (short)b0[2]; va1[3] = (short)b0[3]; va1[4] = (short)b1[0]; va1[5] = (short)b1[1]; va1[6] = (short)b1[2]; va1[7] = (short)b1[3];
            const unsigned w0 = g8::cvt_pk_bf16(pv[8 * s2 + 0], pv[8 * s2 + 1]), w1 = g8::cvt_pk_bf16(pv[8 * s2 + 2], pv[8 * s2 + 3]), w2 = g8::cvt_pk_bf16(pv[8 * s2 + 4], pv[8 * s2 + 5]), w3 = g8::cvt_pk_bf16(pv[8 * s2 + 6], pv[8 * s2 + 7]);
            pb[0] = (short)(w0 & 0xffff); pb[1] = (short)(w0 >> 16); pb[2] = (short)(w1 & 0xffff); pb[3] = (short)(w1 >> 16);
            pb[4] = (short)(w2 & 0xffff); pb[5] = (short)(w2 >> 16); pb[6] = (short)(w3 & 0xffff); pb[7] = (short)(w3 >> 16);
            oT[0] = __builtin_amdgcn_mfma_f32_32x32x16_bf16(va0, pb, oT[0], 0, 0, 0);
            oT[1] = __builtin_amdgcn_mfma_f32_32x32x16_bf16(va1, pb, oT[1], 0, 0, 0);
        }
    };
    auto pair = [&](int ti0, const uint4 (&k0)[4], const uint4 (&k1)[4]) {
        float s0[16], s1[16];
        u16x4 vfa[8], vfb[8];
        v_issue(ti0, vfa); v_issue(ti0 + 1, vfb);
        scores(ti0, k0, s0); scores(ti0 + 1, k1, s1);
        float mt = fmaxf(s0[0], s1[0]);
#pragma unroll
        for (int e = 1; e < 16; ++e) mt = fmaxf(mt, fmaxf(s0[e], s1[e]));
        mt = fmaxf(mt, __shfl_xor(mt, 32));
        const float mn = fmaxf(mrun, mt), corr = __builtin_amdgcn_exp2f(mrun - mn);
        const bool grew = mn > mrun;
        mrun = mn;
        float ls = 0.f;
#pragma unroll
        for (int e = 0; e < 16; ++e) {
            s0[e] = __builtin_amdgcn_exp2f(s0[e] - mn);
            s1[e] = __builtin_amdgcn_exp2f(s1[e] - mn);
            ls += s0[e] + s1[e];
        }
        ls += __shfl_xor(ls, 32);
        lrun = lrun * corr + ls;
        if (__any(grew)) {
#pragma unroll
            for (int e = 0; e < 16; ++e) { oT[0][e] *= corr; oT[1][e] *= corr; }
        }
        v_wait(vfa, vfb);
        pv_acc(vfa, s0); pv_acc(vfb, s1);
    };
    const int te2 = part ? 18 : 6;
    uint4 kA[2][4], kB[2][4];
#pragma unroll
    for (int j = 0; j < 2; ++j) loadK(min(tb + j, 16), kA[j]);
    __syncthreads();
    for (int g0 = tb; g0 < te2; g0 += 4) {
#pragma unroll
        for (int j = 0; j < 2; ++j) loadK(min(g0 + 2 + j, 16), kB[j]);
        pair(g0, kA[0], kA[1]);
#pragma unroll
        for (int j = 0; j < 2; ++j) loadK(min(g0 + 4 + j, 16), kA[j]);
        if (g0 + 2 < te2) pair(g0 + 2, kB[0], kB[1]);
    }
    __syncthreads();
    float* mg = (float*)(smem + AT_MG) + qt * 34 * 64;
    if (part == 1) {
        mg[0 * 64 + lane] = mrun; mg[1 * 64 + lane] = lrun;
#pragma unroll
        for (int e = 0; e < 16; ++e) { mg[(2 + e) * 64 + lane] = oT[0][e]; mg[(18 + e) * 64 + lane] = oT[1][e]; }
    }
    __syncthreads();
    if (part == 0) {
        const float m2 = mg[lane], l2 = mg[64 + lane];
        const float mn = fmaxf(mrun, m2), a1 = __builtin_amdgcn_exp2f(mrun - mn), a2 = __builtin_amdgcn_exp2f(m2 - mn);
        const float inv = 1.0f / (lrun * a1 + l2 * a2);
        bf16_t* op = (bf16_t*)(p->ws + WS_U) + (size_t)(qr * 64 + qcol) * D + 512 + 64 * h + 4 * hh;
#pragma unroll
        for (int dt = 0; dt < 2; ++dt)
#pragma unroll
            for (int g = 0; g < 4; ++g) {
                float o4[4];
#pragma unroll
                for (int j = 0; j < 4; ++j) o4[j] = (oT[dt][4 * g + j] * a1 + mg[(2 + 16 * dt + 4 * g + j) * 64 + lane] * a2) * inv;
                uint2 o; o.x = pk2(o4[0], o4[1]); o.y = pk2(o4[2], o4[3]);
                *(uint2*)(op + 32 * dt + 8 * g) = o;
            }
    }
}
__device__ __forceinline__ void phase_mix3(PP p, unsigned char* smem) {
    for (int u = blockIdx.x; u < 512 + 1024; u += gridDim.x) {
        if (u < 512) hgrn_passA_unit(p, smem, u); else attn_unit(p, smem, u - 512);
    }
}
__device__ __forceinline__ void phase_hgrnC(PP p, unsigned char* smem) {
    for (int u = blockIdx.x; u < 256; u += gridDim.x) hgrn_passC_unit(p, smem, u);
}

constexpr int MOE_TAB_OFF = 143360;
constexpr int CHUNK_TOK = 64;
__device__ __forceinline__ void class_experts(int cls, int& ea, int& eb) {
    const int grp = cls / 6, pi = cls % 6;
    const int la = pi < 3 ? 0 : (pi < 5 ? 1 : 2), lb = pi < 3 ? pi + 1 : (pi < 5 ? pi - 1 : 3);
    ea = grp * 4 + la; eb = grp * 4 + lb;
}
__device__ __forceinline__ void moe_norm_row(const float* hrow, const float* g, const float* sh, const float* scl, float4 (&v)[4], int lane) {
    float s = 0.f;
#pragma unroll
    for (int j = 0; j < 4; ++j) { v[j] = ((const float4*)hrow)[lane + 64 * j]; s += (v[j].x * v[j].x + v[j].y * v[j].y) + (v[j].z * v[j].z + v[j].w * v[j].w); }
    const float rstd = rsqrtf(wave_sum(s) * (1.0f / D) + EPS);
#pragma unroll
    for (int j = 0; j < 4; ++j) {
        const int c4 = lane + 64 * j;
        const float4 gg = ((const float4*)g)[c4], s4 = ((const float4*)sh)[c4], c4v = ((const float4*)scl)[c4];
        v[j].x = v[j].x * rstd * gg.x * (1.f + c4v.x) + s4.x; v[j].y = v[j].y * rstd * gg.y * (1.f + c4v.y) + s4.y;
        v[j].z = v[j].z * rstd * gg.z * (1.f + c4v.z) + s4.z; v[j].w = v[j].w * rstd * gg.w * (1.f + c4v.w) + s4.w;
    }
}
constexpr int WRT_LD = 1028;
__device__ __forceinline__ void phase_route1(PP p, unsigned char* smem, int layer) {
    const int t = tid_opaque(), lane = t & 63, w = t >> 6;
    float* wrT = (float*)smem;
    int* bc = (int*)(smem + 16 * WRT_LD * 4);
    float* sx = (float*)(smem + 16 * WRT_LD * 4 + 256);
    const int tokw = blockIdx.x * CHUNK_TOK + w * 8;
    float4 v[4][4];
#pragma unroll
    for (int q = 0; q < 4; ++q)
#pragma unroll
        for (int j = 0; j < 4; ++j) v[q][j] = ((const float4*)(p->out + (size_t)(tokw + q) * D))[lane + 64 * j];
    {
        float4 wv[8];
#pragma unroll
        for (int q = 0; q < 8; ++q) wv[q] = ((const float4*)p->w_router)[t + NTHREADS * q];
#pragma unroll
        for (int q = 0; q < 8; ++q) {
            const int i = t + NTHREADS * q, c = i >> 2, e4 = (i & 3) * 4;
            wrT[(e4 + 0) * WRT_LD + c] = wv[q].x; wrT[(e4 + 1) * WRT_LD + c] = wv[q].y; wrT[(e4 + 2) * WRT_LD + c] = wv[q].z; wrT[(e4 + 3) * WRT_LD + c] = wv[q].w;
        }
    }
    if (t < 32) bc[t] = 0;
    __syncthreads();
    const float* modv = (const float*)(p->ws + WS_MOD) + (layer ? 2 * 6144 : 0);
    const float* sh = modv + 3 * 1024; const float* scl = modv + 4 * 1024; const float* g = p->norm2_g + layer * D;
    float4* tokinfo = (float4*)(p->ws + WS_TOKINFO);
    bf16_t* U2T = (bf16_t*)(p->ws + WS_U);
    const float brt = p->b_router[lane & 15];
    for (int bt = 0; bt < 2; ++bt) {
        const int tok0 = tokw + bt * 4;
        float ss[4];
#pragma unroll
        for (int q = 0; q < 4; ++q) { ss[q] = 0.f;
#pragma unroll
            for (int j = 0; j < 4; ++j) ss[q] += (v[q][j].x * v[q][j].x + v[q][j].y * v[q][j].y) + (v[q][j].z * v[q][j].z + v[q][j].w * v[q][j].w); }
#pragma unroll
        for (int m = 1; m < 64; m <<= 1) {
#pragma unroll
            for (int q = 0; q < 4; ++q) ss[q] += __shfl_xor(ss[q], m);
        }
#pragma unroll
        for (int q = 0; q < 4; ++q) {
            const float rstd = rsqrtf(ss[q] * (1.0f / D) + EPS);
#pragma unroll
            for (int j = 0; j < 4; ++j) {
                const int c4 = lane + 64 * j;
                const float4 gg = ((const float4*)g)[c4], s4 = ((const float4*)sh)[c4], c4v = ((const float4*)scl)[c4];
                v[q][j].x = v[q][j].x * rstd * gg.x * (1.f + c4v.x) + s4.x; v[q][j].y = v[q][j].y * rstd * gg.y * (1.f + c4v.y) + s4.y;
                v[q][j].z = v[q][j].z * rstd * gg.z * (1.f + c4v.z) + s4.z; v[q][j].w = v[q][j].w * rstd * gg.w * (1.f + c4v.w) + s4.w;
                uint2 o; o.x = pk2(v[q][j].x, v[q][j].y); o.y = pk2(v[q][j].z, v[q][j].w);
                ((uint2*)(U2T + (size_t)(tok0 + q) * D))[c4] = o;
            }
        }
        float a[64];
        {
            typedef float f32x2 __attribute__((ext_vector_type(2)));
            f32x2 p01[4][4], p23[4][4];
#pragma unroll
            for (int j = 0; j < 4; ++j) {
                p01[j][0] = (f32x2){v[0][j].x, v[1][j].x}; p01[j][1] = (f32x2){v[0][j].y, v[1][j].y}; p01[j][2] = (f32x2){v[0][j].z, v[1][j].z}; p01[j][3] = (f32x2){v[0][j].w, v[1][j].w};
                p23[j][0] = (f32x2){v[2][j].x, v[3][j].x}; p23[j][1] = (f32x2){v[2][j].y, v[3][j].y}; p23[j][2] = (f32x2){v[2][j].z, v[3][j].z}; p23[j][3] = (f32x2){v[2][j].w, v[3][j].w};
            }
#pragma unroll
            for (int e = 0; e < 16; ++e) {
                f32x2 a01 = (f32x2){0.f, 0.f}, a23 = (f32x2){0.f, 0.f};
#pragma unroll
                for (int j = 0; j < 4; ++j) {
                    const float4 wv = *(const float4*)(wrT + e * WRT_LD + 4 * (lane + 64 * j));
                    a01 = p01[j][0] * wv.x + a01; a01 = p01[j][1] * wv.y + a01; a01 = p01[j][2] * wv.z + a01; a01 = p01[j][3] * wv.w + a01;
                    a23 = p23[j][0] * wv.x + a23; a23 = p23[j][1] * wv.y + a23; a23 = p23[j][2] * wv.z + a23; a23 = p23[j][3] * wv.w + a23;
                }
                a[e] = a01[0]; a[16 + e] = a01[1]; a[32 + e] = a23[0]; a[48 + e] = a23[1];
            }
        }
#define RS_STEP(N, M) { const bool hi_ = (lane & (M)) != 0; _Pragma("unroll") for (int k_ = 0; k_ < (N); ++k_) { \
            const float mine_ = hi_ ? a[(N) + k_] : a[k_], oth_ = hi_ ? a[k_] : a[(N) + k_]; a[k_] = mine_ + __shfl_xor(oth_, (M)); } }
        RS_STEP(32, 32) RS_STEP(16, 16) RS_STEP(8, 8) RS_STEP(4, 4) RS_STEP(2, 2) RS_STEP(1, 1)
#undef RS_STEP
        const float sgm = sigmoidf_(a[0]);
        sx[(w * 2 + 0) * 64 + lane] = sgm; sx[(w * 2 + 1) * 64 + lane] = sgm + brt;
        if (bt == 0) {
#pragma unroll
            for (int q = 0; q < 4; ++q)
#pragma unroll
                for (int j = 0; j < 4; ++j) v[q][j] = ((const float4*)(p->out + (size_t)(tokw + 4 + q) * D))[lane + 64 * j];
        }
        asm volatile("s_waitcnt lgkmcnt(0)" ::: "memory");
        if (lane < 4) {
            const float* sgp = sx + (w * 2 + 0) * 64 + lane * 16; const float* sbp = sx + (w * 2 + 1) * 64 + lane * 16;
            float sb[16], sg[16];
#pragma unroll
            for (int e = 0; e < 16; ++e) { sg[e] = sgp[e]; sb[e] = sbp[e]; }
            float gs[4];
#pragma unroll
            for (int gI = 0; gI < 4; ++gI) {
                const float a_ = sb[4 * gI], b_ = sb[4 * gI + 1], c_ = sb[4 * gI + 2], d_ = sb[4 * gI + 3];
                gs[gI] = fmaxf(fmaxf(fmaxf(a_ + b_, a_ + c_), fmaxf(a_ + d_, b_ + c_)), fmaxf(b_ + d_, c_ + d_));
            }
            int grp = 0; float gbest = gs[0];
#pragma unroll
            for (int gI = 1; gI < 4; ++gI) if (gs[gI] > gbest) { gbest = gs[gI]; grp = gI; }
            float b4[4], s4v[4];
#pragma unroll
            for (int k = 0; k < 4; ++k) {
                b4[k] = grp == 0 ? sb[k] : grp == 1 ? sb[4 + k] : grp == 2 ? sb[8 + k] : sb[12 + k];
                s4v[k] = grp == 0 ? sg[k] : grp == 1 ? sg[4 + k] : grp == 2 ? sg[8 + k] : sg[12 + k];
            }
            int i1 = 0; float v1 = b4[0];
#pragma unroll
            for (int k = 1; k < 4; ++k) if (b4[k] > v1) { v1 = b4[k]; i1 = k; }
            int i2 = -1; float v2 = -1e30f;
#pragma unroll
            for (int k = 0; k < 4; ++k) if (k != i1 && b4[k] > v2) { v2 = b4[k]; i2 = k; }
            const int ea = min(i1, i2), eb = max(i1, i2);
            const float sa = ea == 0 ? s4v[0] : ea == 1 ? s4v[1] : s4v[2];
            const float sbv = eb == 1 ? s4v[1] : eb == 2 ? s4v[2] : s4v[3];
            const float inv = 1.0f / (sa + sbv);
            const int pidx = ea == 0 ? (eb - 1) : ea == 1 ? (eb + 1) : 5;
            const int cls = grp * 6 + pidx;
            tokinfo[tok0 + lane] = make_float4(__int_as_float(cls), sa * inv, sbv * inv, 0.f);
            atomicAdd(&bc[cls], 1);
        }
    }
    __syncthreads();
    if (t < 32) ((int*)(p->ws + WS_BLKCNT))[layer * 8192 + blockIdx.x * 32 + t] = (t < 24) ? bc[t] : 0;
}
__device__ __forceinline__ void phase_route2(PP p, unsigned char* smem, int layer) {
    const int t = tid_opaque(), lane = t & 63, w = t >> 6;
    int* tb = (int*)(smem + MOE_TAB_OFF); int* tot = tb + 32;
    int* baseS = (int*)smem; int* clsS = baseS + 32; int* rankS = clsS + 64;
    const int* blkcnt = (const int*)(p->ws + WS_BLKCNT) + layer * 8192;
    const float4* tokinfo = (const float4*)(p->ws + WS_TOKINFO);
    const bf16_t* U2T = (const bf16_t*)(p->ws + WS_U);
    g8::u32x4 rw0[8], rw1[8];
#pragma unroll
    for (int i = 0; i < 8; ++i) {
        const g8::u32x4* rp_ = (const g8::u32x4*)(U2T + (size_t)(blockIdx.x * CHUNK_TOK + w * 8 + i) * D);
        rw0[i] = rp_[lane]; rw1[i] = rp_[64 + lane];
    }
    __syncthreads();
    {
        int* partB = rankS + 64; int* partT = partB + 512;
        const int c = t & 31, part = t >> 5;
        int base = 0, total = 0;
#pragma unroll
        for (int i = 0; i < 16; ++i) { const int b = part * 16 + i; const int v = blkcnt[b * 32 + c]; base += (b < (int)blockIdx.x) ? v : 0; total += v; }
        partB[part * 32 + c] = base; partT[part * 32 + c] = total;
        const int myc = __float_as_int(tokinfo[blockIdx.x * CHUNK_TOK + (t & 63)].x);
        __syncthreads();
        if (t < 24) {
            int bs = 0, ts = 0;
#pragma unroll
            for (int q = 0; q < 16; ++q) { bs += partB[q * 32 + t]; ts += partT[q * 32 + t]; }
            baseS[t] = bs; tot[t] = ts;
        }
        if (t >= 64 && t < 64 + CHUNK_TOK) clsS[t - 64] = myc;
    }
    __syncthreads();
    if (t == 0) {
        int* tinfo = tb + 64; int acc = 0;
        for (int c = 0; c < 24; ++c) {
            tb[c] = acc; const int n = (tot[c] + 255) >> 8; int ea, eb; class_experts(c, ea, eb);
            for (int k = 0; k < n; ++k) { tinfo[2 * (acc + k)] = ea | (eb << 8); tinfo[2 * (acc + k) + 1] = tot[c] - 256 * k; }
            acc += n;
        }
        tb[24] = acc;
    }
    if (t >= 64 && t < 64 + 24) { const int c = t - 64; int r = 0; for (int i = 0; i < CHUNK_TOK; ++i) if (clsS[i] == c) rankS[i] = r++; }
    __syncthreads();
    bf16_t* U2S = (bf16_t*)(p->ws + WS_U2S); int* list = (int*)(p->ws + WS_LIST); float2* wl = (float2*)(p->ws + WS_WL);
#pragma unroll
    for (int i = 0; i < 8; ++i) {
        const int li = w * 8 + i, tok = blockIdx.x * CHUNK_TOK + li;
        const int cls = clsS[li];
        const int pos = 256 * tb[cls] + baseS[cls] + rankS[li];
        g8::u32x4* dp = (g8::u32x4*)(U2S + (size_t)pos * D);
        dp[lane] = rw0[i]; dp[64 + lane] = rw1[i];
        if (lane == 0) { const float4 ti = tokinfo[tok]; list[pos] = tok; wl[pos] = make_float2(ti.y, ti.z); }
    }
}
struct MoeSched {
    const int* tb;
    unsigned A, W0, W1;
    int nN, G, c, mode;
    __device__ __forceinline__ bool next(int i, g8::Unit& u) const {
        const int MT = __builtin_amdgcn_readfirstlane(tb[24]);
        int pm, pn; if (!g8::tile_of(i, G, c, MT, nN, pm, pn)) return false;
        const int ee = __builtin_amdgcn_readfirstlane(tb[64 + 2 * pm]), nv = __builtin_amdgcn_readfirstlane(tb[64 + 2 * pm + 1]);
        const int ea = ee & 255, eb = ee >> 8;
        u.pm = pm; u.pn = pn; u.x0 = nv;
        u.a0 = A + (unsigned)pm * 256 * D * 2; u.a1 = u.a0 + 128u * D * 2;
        if (mode == 0) {
            const int e = pn < 4 ? ea : eb; const unsigned roff = ((unsigned)e * 512 + 128 * (pn & 3)) * D * 2;
            u.b0 = W0 + roff; u.b1 = W1 + roff; u.bd = 0; u.x1 = pn < 4 ? 0 : 1;
        } else {
            u.b0 = W0 + ((unsigned)ea * 1024 + 256 * pn) * 512 * 2; u.b1 = u.b0 + 128u * 512 * 2;
            u.bd = (eb - ea) * 1024 * 512 * 2 - 8 * 128; u.x1 = 0;
        }
        return true;
    }
};
struct EpiUp {
    static constexpr bool PERM = true;
    bf16_t* HB; const float2* wl;
    __device__ __forceinline__ void operator()(const g8::f32x4 (&acc)[2][2][4][2], const g8::Unit& u, int wr, int wc, int fr, int fq) const {
        const int row0 = u.pm * 256 + wr * 64 + fr, col0 = u.pn * 128 + wc * 32 + 8 * fq;
#pragma unroll
        for (int ai = 0; ai < 2; ++ai)
#pragma unroll
            for (int m = 0; m < 4; ++m) {
                const int row = row0 + ai * 128 + m * 16;
                const float2 ww = wl[row]; const float wsel = u.x1 ? ww.y : ww.x;
                float hv[8];
#pragma unroll
                for (int n = 0; n < 2; ++n)
#pragma unroll
                    for (int j = 0; j < 4; ++j) { const float gt = acc[ai][0][m][n][j], up = acc[ai][1][m][n][j]; hv[4 * n + j] = silu_fast(gt) * up * wsel; }
                g8::u32x4 o; o.x = g8::cvt_pk_bf16(hv[0], hv[1]); o.y = g8::cvt_pk_bf16(hv[2], hv[3]); o.z = g8::cvt_pk_bf16(hv[4], hv[5]); o.w = g8::cvt_pk_bf16(hv[6], hv[7]);
                *(g8::u32x4*)(HB + (size_t)row * D + col0) = o;
                asm volatile("" ::: "memory");
            }
    }
};
__device__ __forceinline__ void phase_moe_up(PP p, unsigned char* smem, int layer) {
    MoeSched S; S.tb = (const int*)(smem + MOE_TAB_OFF);
    S.A = (unsigned)WS_U2S; S.W0 = (unsigned)(layer ? WS_WG1 : WS_WG0); S.W1 = (unsigned)(layer ? WS_WU1 : WS_WU0);
    S.nN = 8; S.G = gridDim.x; S.c = blockIdx.x; S.mode = 0;
    EpiUp E; E.HB = (bf16_t*)(p->ws + WS_HBUF); E.wl = (const float2*)(p->ws + WS_WL);
    g8::gemm_phase((LAS unsigned char*)smem, (const char*)p->ws, D, D, D, 1 << 30, S, E);
    {
        const int G = gridDim.x, nun = __builtin_amdgcn_readfirstlane(S.tb[24]) * 8, rem = nun % G;
        convert_experts_on_idle(p, smem, layer, rem, 2, 3);
    }
}
struct EpiDown {
    static constexpr bool PERM = true;
    const int* list; const float* g2; float* out;
    __device__ __forceinline__ void operator()(const g8::f32x4 (&acc)[2][2][4][2], const g8::Unit& u, int wr, int wc, int fr, int fq) const {
        const int r0 = wr * 64 + fr, col0 = u.pn * 256 + wc * 32 + 8 * fq;
#pragma unroll
        for (int ai = 0; ai < 2; ++ai)
#pragma unroll
            for (int m = 0; m < 4; ++m) {
                const int r = r0 + ai * 128 + m * 16;
                if (r < u.x0) {
                    const int tok = list[u.pm * 256 + r];
                    float* orow = out + (size_t)tok * D + col0;
#pragma unroll
                    for (int bj = 0; bj < 2; ++bj)
#pragma unroll
                        for (int n = 0; n < 2; ++n) { g8::f32x4* op = (g8::f32x4*)(orow + bj * 128 + n * 4); const g8::f32x4 hv = *op; const g8::f32x4 gvv = *(const g8::f32x4*)(g2 + col0 + bj * 128 + n * 4); *op = hv + gvv * acc[ai][bj][m][n]; }
                }
                asm volatile("" ::: "memory");
            }
    }
};
__device__ __forceinline__ void phase_moe_down(PP p, unsigned char* smem, int layer) {
    MoeSched S; S.tb = (const int*)(smem + MOE_TAB_OFF);
    S.A = (unsigned)WS_HBUF; S.W0 = (unsigned)(layer ? WS_WD1 : WS_WD0); S.W1 = 0u;
    S.nN = 4; S.G = gridDim.x; S.c = blockIdx.x; S.mode = 1;
    EpiDown E; E.list = (const int*)(p->ws + WS_LIST); E.g2 = (const float*)(p->ws + WS_MOD) + (layer ? 2 * 6144 : 0) + 5 * 1024; E.out = p->out;
    g8::gemm_phase((LAS unsigned char*)smem, (const char*)p->ws, D, D, 512, 8, S, E);
    if (layer == 0) {
        const int G = gridDim.x, nun = __builtin_amdgcn_readfirstlane(S.tb[24]) * 4, rem = nun % G;
        convert_experts_on_idle(p, smem, 1, rem, 0, 2);
    }
}

__device__ __forceinline__ void phase_poolA(PP p) {
    const bf16_t* U = (const bf16_t*)(p->ws + WS_U); bf16_t* PA = (bf16_t*)(p->ws + WS_HL);
    const int t_ = tid_opaque();
    for (int e = blockIdx.x * NTHREADS + t_; e < SEQ * 128; e += gridDim.x * NTHREADS) {
        const int tok = e >> 7, c8 = e & 127, g = c8 >> 5, half = 1 << g;
        const int lo = max(tok - half, 0), hi = min(tok + half, SEQ);
        float s[8];
#pragma unroll
        for (int i = 0; i < 8; ++i) s[i] = 0.f;
        for (int r = lo; r < hi; ++r) {
            const uint4 v = *(const uint4*)(U + (size_t)r * D + 8 * c8);
            s[0] += bflo(v.x); s[1] += bfhi(v.x); s[2] += bflo(v.y); s[3] += bfhi(v.y); s[4] += bflo(v.z); s[5] += bfhi(v.z); s[6] += bflo(v.w); s[7] += bfhi(v.w);
        }
        const float ic = 1.0f / (float)(hi - lo);
        const uint4 me = *(const uint4*)(U + (size_t)tok * D + 8 * c8);
        uint4 o;
        o.x = pk2(s[0] * ic - bflo(me.x), s[1] * ic - bfhi(me.x)); o.y = pk2(s[2] * ic - bflo(me.y), s[3] * ic - bfhi(me.y));
        o.z = pk2(s[4] * ic - bflo(me.z), s[5] * ic - bfhi(me.z)); o.w = pk2(s[6] * ic - bflo(me.w), s[7] * ic - bfhi(me.w));
        *(uint4*)(PA + (size_t)tok * D + 8 * c8) = o;
    }
}

__global__ void __launch_bounds__(NTHREADS, 2) mega(Params pk) {
    extern __shared__ __attribute__((aligned(16))) unsigned char smem[];
    volatile LAS unsigned* st = (volatile LAS unsigned*)(LAS unsigned char*)(smem + LDS_BYTES - 16);
    PP p0 = params_here();
    const int lo = p0->ph_lo, hi = p0->ph_hi;
    XcdBarrier bar; bar.bar = (unsigned*)(p0->ws + WS_CTL); bar.x = 0; bar.st = st;
    if (hi - lo > 1) {
        if (threadIdx.x < 4) st[threadIdx.x] = 0u;
        __syncthreads();
        bar = xcd_barrier_post((unsigned*)(p0->ws + WS_CTL), st);
    }
#define IN(k) (lo <= (k) && (k) < hi)
#define SEAM(k) do { if (IN(k) && IN((k) + 1)) xcd_barrier(bar); } while (0)
#define RUN(k, call) do { if (IN(k)) { const int nr_ = (REPEAT_PH == (k)) ? REPEAT_N + 1 : 1; for (int r_ = 0; r_ < nr_; ++r_) { if (r_) xcd_barrier(bar); call; } } } while (0)
    RUN(0, phase_prep(params_here(), smem));
    SEAM(0);
    RUN(1, phase_norm0(params_here()));
    SEAM(1);
    RUN(2, phase_inproj(params_here(), smem));
    SEAM(2);
    RUN(3, phase_mix3(params_here(), smem));
    SEAM(3);
    RUN(4, phase_hgrnB(params_here()));
    SEAM(4);
    RUN(5, phase_hgrnC(params_here(), smem));
    SEAM(5);
    RUN(6, phase_outproj(params_here(), smem));
    SEAM(6);
    for (int layer = 0; layer < 2; ++layer) {
        if (layer == 1) {
            RUN(12, phase_normpool(params_here(), smem));
            SEAM(12);
            RUN(13, phase_poolgemm(params_here(), smem));
            SEAM(13);
        }
        const int pb = layer ? 14 : 7;
        RUN(pb, phase_route1(params_here(), smem, layer));
        SEAM(pb);
        RUN(pb + 1, phase_route2(params_here(), smem, layer));
        SEAM(pb + 1);
        RUN(pb + 2, phase_moe_up(params_here(), smem, layer));
        SEAM(pb + 2);
        RUN(pb + 3, phase_moe_down(params_here(), smem, layer));
        if (IN(pb + 3) && hi > pb + 4) xcd_barrier(bar);
    }
    RUN(18, phase_final(params_here()));
#undef IN
#undef SEAM
#undef RUN
}

extern "C" void kernel_launch(void* const* d_in, const int* in_sizes, int n_in, void* d_out, int out_size, void* d_ws, size_t ws_size, hipStream_t stream) {
    static int grid = 0;
    if (grid == 0) {
        if (n_in != 21 || in_sizes[0] != SEQ * D || out_size != SEQ * D || ws_size < WS_END) {
            fprintf(stderr, "kernel_launch: unexpected shapes (n_in %d, in0 %d, out %d, ws %zu < %zu); nothing launched\n", n_in, n_in > 0 ? in_sizes[0] : -1, out_size, ws_size, (size_t)WS_END);
            grid = -1; return;
        }
        int dev = 0, cus = 0, per_cu = 0;
        if (hipGetDevice(&dev) != hipSuccess || hipDeviceGetAttribute(&cus, hipDeviceAttributeMultiprocessorCount, dev) != hipSuccess) { grid = -1; return; }
        if (hipFuncSetAttribute((const void*)mega, hipFuncAttributeMaxDynamicSharedMemorySize, LDS_BYTES) != hipSuccess) { fprintf(stderr, "kernel_launch: hipFuncSetAttribute failed\n"); grid = -1; return; }
        if (hipOccupancyMaxActiveBlocksPerMultiprocessor(&per_cu, (const void*)mega, NTHREADS, LDS_BYTES) != hipSuccess || per_cu < 1) {
            fprintf(stderr, "kernel_launch: occupancy query reports %d blocks per CU\n", per_cu); per_cu = 1;
        }
        (void)hipGetLastError();
        grid = cus;
    }
    if (grid < 0) return;
    (void)hipMemsetAsync((char*)d_ws + WS_CTL, 0, CTL_BYTES, stream);
    Params p{};
    const float** pp = (const float**)&p;
    for (int i = 0; i < 21; ++i) pp[i] = (const float*)d_in[i];
    p.out = (float*)d_out; p.ws = (unsigned char*)d_ws;
#if N_LAUNCH_MODE == 1
    p.ph_lo = 0; p.ph_hi = NPH;
    void* args[] = {&p};
    hipError_t e = hipLaunchCooperativeKernel((const void*)mega, dim3(grid), dim3(NTHREADS), args, LDS_BYTES, stream);
    if (e != hipSuccess) fprintf(stderr, "kernel_launch: cooperative launch failed: %s (grid %d)\n", hipGetErrorString(e), grid);
#else
    for (int ph = 0; ph < NPH; ++ph) {
        p.ph_lo = ph; p.ph_hi = ph + 1;
        hipLaunchKernelGGL(mega, dim3(grid), dim3(NTHREADS), LDS_BYTES, stream, p);
    }
#endif
}
```

```cpp
#include <hip/hip_runtime.h>
#include <cstdio>
#include <cstdint>

#ifndef REPEAT_PH
#define REPEAT_PH -1
#define REPEAT_N 0
#endif
#ifndef N_LAUNCH_MODE
#define N_LAUNCH_MODE 1
#endif

typedef unsigned short bf16_t;
typedef short bf16x8 __attribute__((ext_vector_type(8)));
typedef float f32x16 __attribute__((ext_vector_type(16)));
typedef __bf16 bf16x2_t __attribute__((ext_vector_type(2)));
namespace g8 { typedef float f32x4 __attribute__((ext_vector_type(4))); typedef unsigned u32x4 __attribute__((ext_vector_type(4))); }
#define LAS __attribute__((address_space(3)))

constexpr int D = 1024, SEQ = 16384, CTXL = 256, NTOK = SEQ + CTXL, INW = 4096;
constexpr int NPH = 19;
constexpr int NTHREADS = 512;
constexpr int LDS_BYTES = 147456;
constexpr float EPS = 1e-6f;

constexpr size_t MiB = 1024 * 1024;
constexpr size_t WS_CTL = 0;
constexpr size_t CTL_BYTES = 65536;
constexpr size_t CTL_CNT_OFF = 16384;
constexpr size_t WS_MOD = 65536;
constexpr size_t WS_WIN = 1 * MiB;
constexpr size_t WS_WOUT = 9 * MiB;
constexpr size_t WS_WPOOL = 11 * MiB;
constexpr size_t WS_WG0 = 12 * MiB;
constexpr size_t WS_WU0 = 28 * MiB;
constexpr size_t WS_WD0 = 44 * MiB;
constexpr size_t WS_U = 60 * MiB;
constexpr size_t WS_PROJ = 100 * MiB;
constexpr size_t WS_WG1 = WS_PROJ;
constexpr size_t WS_WU1 = WS_PROJ + 16 * MiB;
constexpr size_t WS_WD1 = WS_PROJ + 32 * MiB;
constexpr size_t WS_HBUF = WS_PROJ + 48 * MiB;
constexpr size_t WS_HL = 230 * MiB;
constexpr size_t WS_HS = 262 * MiB;
constexpr size_t WS_HD = 294 * MiB;
constexpr size_t WS_U2S = WS_HL;
constexpr size_t WS_LIST = 295 * MiB;
constexpr size_t WS_WL = 295 * MiB + 128 * 1024;
constexpr size_t WS_TOKINFO = 295 * MiB + 512 * 1024;
constexpr size_t WS_BLKCNT = 296 * MiB;
constexpr size_t WS_END = 297 * MiB;

__device__ __forceinline__ unsigned f2bf(float f) { return (unsigned)__builtin_bit_cast(unsigned short, (__bf16)f); }
__device__ __forceinline__ float bf2f(unsigned b) { return __uint_as_float(b << 16); }
__device__ __forceinline__ unsigned pk2(float lo, float hi) { bf16x2_t v; v[0] = (__bf16)lo; v[1] = (__bf16)hi; return __builtin_bit_cast(unsigned, v); }
__device__ __forceinline__ float bflo(unsigned w) { return __uint_as_float(w << 16); }
__device__ __forceinline__ float bfhi(unsigned w) { return __uint_as_float(w & 0xffff0000u); }
__device__ __forceinline__ float wave_sum(float v) {
#pragma unroll
    for (int o = 1; o < 64; o <<= 1) v += __shfl_xor(v, o);
    return v;
}
__device__ __forceinline__ int tid_opaque() { int t = threadIdx.x; asm volatile("" : "+v"(t)); return t; }
__device__ __forceinline__ float sigmoidf_(float x) { return 1.0f / (1.0f + __expf(-x)); }
__device__ __forceinline__ float siluf_(float x) { return x / (1.0f + __expf(-x)); }
__device__ __forceinline__ float silu_fast(float x) { return x * __builtin_amdgcn_rcpf(1.0f + __builtin_amdgcn_exp2f(-1.4426950408889634f * x)); }
__device__ __forceinline__ float dot2bf(unsigned a, unsigned b, float acc) {
    return __builtin_amdgcn_fdot2_f32_bf16(__builtin_bit_cast(bf16x2_t, a), __builtin_bit_cast(bf16x2_t, b), acc, false);
}

#define XB_TMO      128
#define XB_XCNT(j)  (256  + 64 * (j))
#define XB_XSUB(j)  (1280 + 64 * (j))
#define XB_XGEN(j)  (2304 + 64 * (j))
#define XB_TOP      3328
#define XB_TOPGEN   3392
#define XCD_BAR_WORDS 3456
#define XB_SPIN_CAP (1u << 22)
__device__ __forceinline__ unsigned xb_ld(unsigned* p)              { return __hip_atomic_load(p, __ATOMIC_RELAXED, __HIP_MEMORY_SCOPE_AGENT); }
__device__ __forceinline__ unsigned xb_add(unsigned* p, unsigned v) { return __hip_atomic_fetch_add(p, v, __ATOMIC_RELAXED, __HIP_MEMORY_SCOPE_AGENT); }
__device__ __forceinline__ unsigned xb_xcc_id() { return (unsigned)__builtin_amdgcn_s_getreg((3 << 11) | 20) & 0xFu; }
#define XB_SPIN(cond, bar) do { unsigned _sp = 0; while (cond) { \
    if ((++_sp & 255u) == 0u) { if (xb_ld(&(bar)[XB_TMO])) break; if (_sp > XB_SPIN_CAP) { atomicAdd(&(bar)[XB_TMO], 1u); break; } } } } while (0)
struct XcdBarrier { unsigned* bar; unsigned x; volatile LAS unsigned* st; };
__device__ __forceinline__ XcdBarrier xcd_barrier_post(unsigned* bar, volatile LAS unsigned* st) {
    XcdBarrier b; b.bar = bar; b.x = xb_xcc_id(); b.st = st;
    if (threadIdx.x == 0) (void)xb_add(&bar[XB_XCNT(b.x)], 1u);
    return b;
}
__device__ __forceinline__ void xcd_barrier_complete(unsigned* bar, unsigned x, unsigned& nloc, unsigned& nx) {
    const unsigned G = gridDim.x * gridDim.y * gridDim.z;
    unsigned sum, cnt, mine, sp = 0u;
    for (;;) {
        sum = 0u; cnt = 0u; mine = 0u;
#pragma unroll
        for (unsigned j = 0; j < 16; ++j) { const unsigned c = xb_ld(&bar[XB_XCNT(j)]); sum += c; cnt += (c > 0u) ? 1u : 0u; mine = (j == x) ? c : mine; }
        if (sum == G) break;
        __builtin_amdgcn_s_sleep(1);
        if ((++sp & 255u) == 0u) { if (xb_ld(&bar[XB_TMO])) break; if (sp > XB_SPIN_CAP) { atomicAdd(&bar[XB_TMO], 1u); break; } }
    }
    nloc = mine > 0u ? mine : 1u; nx = cnt > 0u ? cnt : 1u;
}
__device__ __forceinline__ void xcd_barrier(const XcdBarrier& b) {
    asm volatile("s_waitcnt vmcnt(0)" ::: "memory");
    __syncthreads();
    if (threadIdx.x == 0) {
        unsigned* bar = b.bar;
        __builtin_amdgcn_s_waitcnt(0);
        unsigned nloc = b.st[0], nx = b.st[1];
        if (nloc == 0u) { xcd_barrier_complete(bar, b.x, nloc, nx); b.st[0] = nloc; b.st[1] = nx; }
        const unsigned old = xb_add(&bar[XB_XSUB(b.x)], 1u);
        const unsigned gen = old / nloc;
        if (old + 1u == (gen + 1u) * nloc) {
            __builtin_amdgcn_fence(__ATOMIC_RELEASE, "agent");
            asm volatile("s_waitcnt vmcnt(0)" ::: "memory");
            const unsigned og = xb_add(&bar[XB_TOP], 1u);
            const unsigned tg = og / nx;
            if (og + 1u == (tg + 1u) * nx) xb_add(&bar[XB_TOPGEN], 1u);
            else XB_SPIN(xb_ld(&bar[XB_TOPGEN]) == tg, bar);
            __builtin_amdgcn_fence(__ATOMIC_ACQUIRE, "agent");
            xb_add(&bar[XB_XGEN(b.x)], 1u);
            asm volatile("s_waitcnt vmcnt(0)" ::: "memory");
        } else {
            XB_SPIN(xb_ld(&bar[XB_XGEN(b.x)]) == gen, bar);
            __builtin_amdgcn_fence(__ATOMIC_ACQUIRE, "agent");
            asm volatile("s_waitcnt vmcnt(0)" ::: "memory");
        }
    }
    __syncthreads();
}

struct Params {
    const float *x, *c, *ctx, *c_ctx, *w_mod, *b_mod, *norm1_g, *norm2_g, *w_in, *w_out, *lb_logits, *a_norm_g, *rpb,
                *w_pool, *pool_scale, *w_router, *b_router, *w_gate, *w_up, *w_down, *final_g;
    float* out; unsigned char* ws; int ph_lo, ph_hi;
};

typedef const __attribute__((address_space(4))) Params* PP;
__device__ __forceinline__ PP params_here() {
    unsigned long long v = (unsigned long long)__builtin_amdgcn_kernarg_segment_ptr();
    asm volatile("" : "+s"(v));
    return (PP)v;
}
__device__ __forceinline__ void transpose_item(const float* W, int K, int N, bf16_t* WT, float* scr, int item, int lane) {
    const int nblk = N / 64, kb = item / nblk, nb = item % nblk, k0 = 64 * kb, n0 = 64 * nb;
    g8::f32x4 tv[16];
#pragma unroll
    for (int i = 0; i < 16; ++i) tv[i] = __builtin_nontemporal_load((const g8::f32x4*)(W + (size_t)(k0 + 4 * i + (lane >> 4)) * N + n0) + (lane & 15));
#pragma unroll
    for (int i = 0; i < 16; ++i) {
        float* s = scr + (4 * i + (lane >> 4)) * 65 + 4 * (lane & 15);
        s[0] = tv[i][0]; s[1] = tv[i][1]; s[2] = tv[i][2]; s[3] = tv[i][3];
    }
    asm volatile("s_waitcnt lgkmcnt(0)" ::: "memory");
    const int c = lane & 7;
#pragma unroll
    for (int j = 0; j < 8; ++j) {
        const int n = (lane >> 3) + 8 * j; const float* s = scr + (8 * c) * 65 + n;
        uint4 o; o.x = pk2(s[0 * 65], s[1 * 65]); o.y = pk2(s[2 * 65], s[3 * 65]); o.z = pk2(s[4 * 65], s[5 * 65]); o.w = pk2(s[6 * 65], s[7 * 65]);
        *(uint4*)(WT + (size_t)(n0 + n) * K + k0 + 8 * c) = o;
    }
    asm volatile("s_waitcnt lgkmcnt(0)" ::: "memory");
}
__device__ __forceinline__ void convert_expert_item(PP p, int layer, bf16_t* WG, bf16_t* WU, bf16_t* WD, float* scr, int r, int lane) {
    const int mi = r >> 7, item = r & 127, mat = mi >> 4, e = mi & 15;
    const size_t eoff = (size_t)(layer * 16 + e) * 1024 * 512;
    if (mat == 0) transpose_item(p->w_gate + eoff, 1024, 512, WG + (size_t)e * 512 * 1024, scr, item, lane);
    else if (mat == 1) transpose_item(p->w_up + eoff, 1024, 512, WU + (size_t)e * 512 * 1024, scr, item, lane);
    else transpose_item(p->w_down + eoff, 512, 1024, WD + (size_t)e * 1024 * 512, scr, item, lane);
}
__device__ __forceinline__ void phase_prep(PP p, unsigned char* smem) {
    const int t = tid_opaque(), lane = t & 63, w = t >> 6;
    float* modv = (float*)(p->ws + WS_MOD);
    {
        float* sc = (float*)smem; float* scc = sc + 1024; float* red = scc + 1024;
        for (int i = t; i < 1024; i += NTHREADS) { sc[i] = siluf_(p->c[i]); scc[i] = siluf_(p->c_ctx[i]); }
        __syncthreads();
        for (int u = blockIdx.x; u < 192; u += gridDim.x) {
            const int which = u / 96, col = (u % 96) * 64 + lane;
            const float* W = p->w_mod + (size_t)which * 1024 * 6144 + col;
            float a1 = 0.f, a2 = 0.f;
#pragma unroll 8
            for (int k = 128 * w; k < 128 * w + 128; ++k) { const float wv = W[(size_t)k * 6144]; a1 += sc[k] * wv; a2 += scc[k] * wv; }
            red[(w * 2 + 0) * 64 + lane] = a1; red[(w * 2 + 1) * 64 + lane] = a2;
            __syncthreads();
            if (t < 128) {
                const int sel = t >> 6, l = t & 63; float s = 0.f;
#pragma unroll
                for (int ww = 0; ww < 8; ++ww) s += red[(ww * 2 + sel) * 64 + l];
                const int cc = (u % 96) * 64 + l;
                s += p->b_mod[which * 6144 + cc];
                if (which == 0) modv[sel * 6144 + cc] = s; else if (sel == 0) modv[2 * 6144 + cc] = s;
            }
            __syncthreads();
        }
    }
    float* scr = (float*)smem + w * (64 * 65);
    const int gw = blockIdx.x * 8 + w, NGW = gridDim.x * 8;
    constexpr int I_IN = 16 * 64, I_OUT = 16 * 16, I_POOL = 4 * 16;
    for (int it = gw; it < I_IN + I_OUT + I_POOL; it += NGW) {
        int r = it;
        if (r < I_IN) { transpose_item(p->w_in, 1024, 4096, (bf16_t*)(p->ws + WS_WIN), scr, r, lane); continue; } r -= I_IN;
        if (r < I_OUT) { transpose_item(p->w_out, 1024, 1024, (bf16_t*)(p->ws + WS_WOUT), scr, r, lane); continue; } r -= I_OUT;
        { const int g = r >> 4; transpose_item(p->w_pool + (size_t)g * 65536, 256, 256, (bf16_t*)(p->ws + WS_WPOOL) + (size_t)g * 65536, scr, r & 15, lane); }
    }
}

__device__ __forceinline__ void norm_mod_rows4(const float* const (&xrow)[4], const float* g, const float* const (&shift)[4], const float* const (&scale)[4], bf16_t* const (&orow)[4], int lane) {
    float4 v[4][4]; float s[4];
#pragma unroll
    for (int q = 0; q < 4; ++q)
#pragma unroll
        for (int j = 0; j < 4; ++j) v[q][j] = ((const float4*)xrow[q])[lane + 64 * j];
#pragma unroll
    for (int q = 0; q < 4; ++q) { s[q] = 0.f;
#pragma unroll
        for (int j = 0; j < 4; ++j) s[q] += (v[q][j].x * v[q][j].x + v[q][j].y * v[q][j].y) + (v[q][j].z * v[q][j].z + v[q][j].w * v[q][j].w); }
#pragma unroll
    for (int m = 1; m < 64; m <<= 1) {
#pragma unroll
        for (int q = 0; q < 4; ++q) s[q] += __shfl_xor(s[q], m);
    }
#pragma unroll
    for (int q = 0; q < 4; ++q) {
        const float rstd = rsqrtf(s[q] * (1.0f / D) + EPS);
#pragma unroll
        for (int j = 0; j < 4; ++j) {
            const int c4 = lane + 64 * j;
            const float4 gg = ((const float4*)g)[c4], sh = ((const float4*)shift[q])[c4], sc = ((const float4*)scale[q])[c4];
            const float a = v[q][j].x * rstd * gg.x * (1.f + sc.x) + sh.x, b = v[q][j].y * rstd * gg.y * (1.f + sc.y) + sh.y;
            const float c = v[q][j].z * rstd * gg.z * (1.f + sc.z) + sh.z, d = v[q][j].w * rstd * gg.w * (1.f + sc.w) + sh.w;
            uint2 o; o.x = pk2(a, b); o.y = pk2(c, d);
            ((uint2*)orow[q])[c4] = o;
        }
    }
}
__device__ __forceinline__ void phase_norm0(PP p) {
    const int t_ = tid_opaque(); const int lane = t_ & 63, gw = blockIdx.x * 8 + (t_ >> 6), NGW = gridDim.x * 8;
    const float* modv = (const float*)(p->ws + WS_MOD);
    bf16_t* U = (bf16_t*)(p->ws + WS_U);
    for (int r0 = gw * 4; r0 < NTOK; r0 += NGW * 4) {
        const float* xr[4]; const float* shp[4]; const float* scp[4]; bf16_t* orow[4];
#pragma unroll
        for (int q = 0; q < 4; ++q) {
            const int r = r0 + q;
            const bool isc = r < CTXL;
            xr[q] = isc ? p->ctx + (size_t)r * D : p->x + (size_t)(r - CTXL) * D;
            shp[q] = modv + (isc ? 6144 : 0); scp[q] = modv + (isc ? 6144 : 0) + 1024;
            orow[q] = U + (size_t)r * D;
        }
        norm_mod_rows4(xr, p->norm1_g, shp, scp, orow, lane);
    }
}
__device__ __forceinline__ void phase_final(PP p) {
    const int t_ = tid_opaque(); const int lane = t_ & 63, gw = blockIdx.x * 8 + (t_ >> 6), NGW = gridDim.x * 8;
    for (int r0 = gw * 4; r0 < SEQ; r0 += NGW * 4) {
        float4 v[4][4]; float s[4];
#pragma unroll
        for (int q = 0; q < 4; ++q)
#pragma unroll
            for (int j = 0; j < 4; ++j) v[q][j] = ((const float4*)(p->out + (size_t)(r0 + q) * D))[lane + 64 * j];
#pragma unroll
        for (int q = 0; q < 4; ++q) { s[q] = 0.f;
#pragma unroll
            for (int j = 0; j < 4; ++j) s[q] += (v[q][j].x * v[q][j].x + v[q][j].y * v[q][j].y) + (v[q][j].z * v[q][j].z + v[q][j].w * v[q][j].w); }
#pragma unroll
        for (int m = 1; m < 64; m <<= 1) {
#pragma unroll
            for (int q = 0; q < 4; ++q) s[q] += __shfl_xor(s[q], m);
        }
#pragma unroll
        for (int q = 0; q < 4; ++q) {
            const float rstd = rsqrtf(s[q] * (1.0f / D) + EPS);
#pragma unroll
            for (int j = 0; j < 4; ++j) {
                const float4 gg = ((const float4*)p->final_g)[lane + 64 * j];
                float4 o; o.x = v[q][j].x * rstd * gg.x; o.y = v[q][j].y * rstd * gg.y; o.z = v[q][j].z * rstd * gg.z; o.w = v[q][j].w * rstd * gg.w;
                ((float4*)(p->out + (size_t)(r0 + q) * D))[lane + 64 * j] = o;
            }
        }
    }
}
__device__ __forceinline__ void phase_normpool(PP p, unsigned char* smem) {
    const int t = tid_opaque(), lane = t & 63, w = t >> 6;
    const float* modv = (const float*)(p->ws + WS_MOD) + 2 * 6144;
    const float* g = p->norm1_g + D; const float* sh = modv; const float* scl = modv + 1024;
    bf16_t* PA = (bf16_t*)(p->ws + WS_HL);
    for (int hf = 0; hf < 2; ++hf) {
        const int T0 = blockIdx.x * 64 + 32 * hf, R0 = T0 - 8;
        __syncthreads();
#pragma unroll
        for (int bt = 0; bt < 2; ++bt) {
            float4 v[3][4];
#pragma unroll
            for (int q = 0; q < 3; ++q) {
                const int tok = min(max(R0 + w * 6 + bt * 3 + q, 0), SEQ - 1);
#pragma unroll
                for (int j = 0; j < 4; ++j) v[q][j] = ((const float4*)(p->out + (size_t)tok * D))[lane + 64 * j];
            }
#pragma unroll
            for (int q = 0; q < 3; ++q) {
                float s = 0.f;
#pragma unroll
                for (int j = 0; j < 4; ++j) s += (v[q][j].x * v[q][j].x + v[q][j].y * v[q][j].y) + (v[q][j].z * v[q][j].z + v[q][j].w * v[q][j].w);
                const float rstd = rsqrtf(wave_sum(s) * (1.0f / D) + EPS);
                bf16_t* lrow = (bf16_t*)smem + (w * 6 + bt * 3 + q) * D;
#pragma unroll
                for (int j = 0; j < 4; ++j) {
                    const int c4 = lane + 64 * j;
                    const float4 gg = ((const float4*)g)[c4], s4 = ((const float4*)sh)[c4], c4v = ((const float4*)scl)[c4];
                    uint2 o;
                    o.x = pk2(v[q][j].x * rstd * gg.x * (1.f + c4v.x) + s4.x, v[q][j].y * rstd * gg.y * (1.f + c4v.y) + s4.y);
                    o.y = pk2(v[q][j].z * rstd * gg.z * (1.f + c4v.z) + s4.z, v[q][j].w * rstd * gg.w * (1.f + c4v.w) + s4.w);
                    ((uint2*)lrow)[c4] = o;
                }
            }
        }
        __syncthreads();
        {
            const int c8 = t & 127, run = t >> 7, gq = c8 >> 5, half = 1 << gq;
            const bf16_t* base = (const bf16_t*)smem + 8 * c8;
            const int tok0 = T0 + 8 * run;
            float s[8];
#pragma unroll
            for (int i = 0; i < 8; ++i) s[i] = 0.f;
            int lo = max(tok0 - half, 0), hi = min(tok0 + half, SEQ);
            for (int r = lo; r < hi; ++r) {
                const uint4 vv = *(const uint4*)(base + (r - R0) * D);
                s[0] += bflo(vv.x); s[1] += bfhi(vv.x); s[2] += bflo(vv.y); s[3] += bfhi(vv.y); s[4] += bflo(vv.z); s[5] += bfhi(vv.z); s[6] += bflo(vv.w); s[7] += bfhi(vv.w);
            }
#pragma unroll
            for (int q = 0; q < 8; ++q) {
                const int tok = tok0 + q;
                if (q > 0) {
                    const int nlo = max(tok - half, 0), nhi = min(tok + half, SEQ);
                    if (nhi > hi) { const uint4 vv = *(const uint4*)(base + (hi - R0) * D);
                        s[0] += bflo(vv.x); s[1] += bfhi(vv.x); s[2] += bflo(vv.y); s[3] += bfhi(vv.y); s[4] += bflo(vv.z); s[5] += bfhi(vv.z); s[6] += bflo(vv.w); s[7] += bfhi(vv.w); }
                    if (nlo > lo) { const uint4 vv = *(const uint4*)(base + (lo - R0) * D);
                        s[0] -= bflo(vv.x); s[1] -= bfhi(vv.x); s[2] -= bflo(vv.y); s[3] -= bfhi(vv.y); s[4] -= bflo(vv.z); s[5] -= bfhi(vv.z); s[6] -= bflo(vv.w); s[7] -= bfhi(vv.w); }
                    lo = nlo; hi = nhi;
                }
                const float ic = 1.0f / (float)(hi - lo);
                const uint4 me = *(const uint4*)(base + (tok - R0) * D);
                uint4 o;
                o.x = pk2(s[0] * ic - bflo(me.x), s[1] * ic - bfhi(me.x)); o.y = pk2(s[2] * ic - bflo(me.y), s[3] * ic - bfhi(me.y));
                o.z = pk2(s[4] * ic - bflo(me.z), s[5] * ic - bfhi(me.z)); o.w = pk2(s[6] * ic - bflo(me.w), s[7] * ic - bfhi(me.w));
                *(uint4*)(PA + (size_t)tok * D + 8 * c8) = o;
            }
        }
    }
}

namespace g8 {
constexpr int BM = 256, BK = 64, HALF = 128, HTB = HALF * BK * 2, STAGE_BYTES = 8 * HTB, NXCD = 8, WGM = 8;
__device__ __forceinline__ int lds_byte(int r, int c) { const int st = (r >> 4) * 2 + (c >> 5), rr = r & 15, cc = c & 31, ob = rr * 64 + cc * 2; return st * 1024 + (ob ^ (((ob >> 9) & 1) << 5)); }
__device__ __forceinline__ void stage_rc(int b, int& R, int& C) { const int st = b / 1024, sb = b % 1024, swz = sb ^ (((sb >> 9) & 1) << 5); R = (st >> 1) * 16 + swz / 64; C = (st & 1) * 32 + (swz % 64) / 2; }
__device__ __forceinline__ int perm32(int rho) { const int n = rho >> 4, i = rho & 15; return 8 * (i >> 2) + 4 * n + (i & 3); }
__device__ __forceinline__ unsigned cvt_pk_bf16(float lo, float hi) { return pk2(lo, hi); }

struct Unit { unsigned a0, a1, b0, b1; int bd; int pm, pn, x0, x1; };
__device__ __forceinline__ bool tile_of(int i, int G, int c, int nM, int nN, int& pm, int& pn) {
    const int nwg = nM * nN; const long L = (long)i * G + c; if (L >= nwg) return false;
    int wgid = (int)L; { const int q = nwg / NXCD, r = nwg % NXCD, xcd = wgid % NXCD, off = wgid / NXCD; wgid = (xcd < r ? xcd * (q + 1) : r * (q + 1) + (xcd - r) * q) + off; }
    const int nig = WGM * nN, gid = wgid / nig, fm = gid * WGM, gsz = (nM - fm) < WGM ? (nM - fm) : WGM;
    pm = fm + ((wgid % nig) % gsz); pn = (wgid % nig) / gsz; return true;
}
template <class Epi, class Sched>
__device__ __forceinline__ void gemm_phase(LAS unsigned char* lds, const char* base, const int K, const int lda, const int ldb, const int tsplit, const Sched& S, const Epi& E) {
    const int tid = tid_opaque(), wid = __builtin_amdgcn_readfirstlane(tid >> 6), lane = tid & 63, wr = wid >> 2, wc = wid & 3, fr = lane & 15, fq = lane >> 4;
    const int nt = K / BK;
    unsigned voffA[2], voffB[2];
#pragma unroll
    for (int i = 0; i < 2; ++i) { int R, C; stage_rc(tid * 16 + i * 8192, R, C); const int Rb = Epi::PERM ? ((R & ~31) + perm32(R & 31)) : R;
        voffA[i] = (unsigned)(R * lda + C) * 2u; voffB[i] = (unsigned)(Rb * ldb + C) * 2u; }
    constexpr unsigned kstep = BK * 2;
    const unsigned ldsw = (unsigned)wid * 1024u;
    const int aoff = lds_byte(wr * 64 + fr, fq * 8), boff = lds_byte(wc * 32 + fr, fq * 8);
#define G8_SA(b, h) (((b) * 2 + (h)) * HTB)
#define G8_SB(b, h) ((4 + (b) * 2 + (h)) * HTB)
#define G8_STAGE(bufoff, goff, voff) do { _Pragma("unroll") for (int _i = 0; _i < 2; ++_i) \
        __builtin_amdgcn_global_load_lds((const unsigned*)(base + (size_t)((voff)[_i] + (unsigned)(goff))), (LAS unsigned*)(lds + (bufoff) + ldsw + _i * 8192), 16, 0, 0); } while (0)
#define G8_LDA(dst, b, h) do { _Pragma("unroll") for (int m = 0; m < 4; ++m) _Pragma("unroll") for (int k = 0; k < 2; ++k) dst[m][k] = *(const LAS bf16x8*)(lds + G8_SA(b, h) + aoff + m * 2048 + k * 1024); } while (0)
#define G8_LDB(dst, b, h) do { _Pragma("unroll") for (int n = 0; n < 2; ++n) _Pragma("unroll") for (int k = 0; k < 2; ++k) dst[n][k] = *(const LAS bf16x8*)(lds + G8_SB(b, h) + boff + n * 2048 + k * 1024); } while (0)
#define G8_MMA(ai, bj, At, Bt) do { __builtin_amdgcn_s_setprio(1); _Pragma("unroll") for (int m = 0; m < 4; ++m) _Pragma("unroll") for (int n = 0; n < 2; ++n) _Pragma("unroll") for (int k = 0; k < 2; ++k) \
        acc[ai][bj][m][n] = __builtin_amdgcn_mfma_f32_16x16x32_bf16(Bt[n][k], At[m][k], acc[ai][bj][m][n], 0, 0, 0); __builtin_amdgcn_s_setprio(0); } while (0)
#define G8_WAIT_V(n) asm volatile("s_waitcnt vmcnt(" #n ")" ::: "memory")
#define G8_WAIT_L(n) asm volatile("s_waitcnt lgkmcnt(" #n ")" ::: "memory")
#define G8_BAR __builtin_amdgcn_s_barrier()
#define G8_SCHED __builtin_amdgcn_sched_barrier(0)
#define G8_BK(u, h, tt) ((u).b##h + (unsigned)(tt) * kstep + (unsigned)(((tt) >= tsplit) ? (u).bd : 0))
#define G8_P(off) ((unsigned)(off))
    Unit cur, nxt; int ui = 0;
    if (!S.next(0, cur)) return;
    f32x4 acc[2][2][4][2];
#pragma unroll
    for (int a = 0; a < 2; ++a)
#pragma unroll
        for (int b = 0; b < 2; ++b)
#pragma unroll
            for (int m = 0; m < 4; ++m)
#pragma unroll
                for (int n = 0; n < 2; ++n) acc[a][b][m][n] = (f32x4){0.f, 0.f, 0.f, 0.f};
    bf16x8 At[4][2], B0[2][2], B1[2][2];
    asm volatile("s_waitcnt vmcnt(0) lgkmcnt(0)" ::: "memory");
    __syncthreads();
    G8_STAGE(G8_SB(0, 0), G8_P(G8_BK(cur, 0, 0)), voffB); G8_STAGE(G8_SB(0, 1), G8_P(G8_BK(cur, 1, 0)), voffB); G8_STAGE(G8_SA(0, 0), G8_P(cur.a0), voffA); G8_STAGE(G8_SA(0, 1), G8_P(cur.a1), voffA);
    if (wr == 1) G8_BAR;
    G8_WAIT_V(2); G8_BAR;
    G8_STAGE(G8_SB(1, 0), G8_P(G8_BK(cur, 0, 1)), voffB); G8_STAGE(G8_SA(1, 0), G8_P(cur.a0 + kstep), voffA); G8_STAGE(G8_SB(1, 1), G8_P(G8_BK(cur, 1, 1)), voffB);
    G8_WAIT_V(6); G8_BAR;
    for (;;) {
        const bool has_next = S.next(ui + 1, nxt);
        if (!has_next) nxt = cur;
        for (int t = 0; t < nt; t += 2) {
            const bool last = (t == nt - 2);
            const unsigned a1 = G8_P(cur.a1 + (unsigned)(t + 1) * kstep);
            const int t2 = last ? 0 : t + 2, t3 = t2 + 1;
            const unsigned a20 = G8_P((last ? nxt.a0 : cur.a0) + (unsigned)t2 * kstep), a21 = G8_P((last ? nxt.a1 : cur.a1) + (unsigned)t2 * kstep);
            const unsigned b20 = G8_P(last ? G8_BK(nxt, 0, t2) : G8_BK(cur, 0, t2)), b21 = G8_P(last ? G8_BK(nxt, 1, t2) : G8_BK(cur, 1, t2));
            const unsigned a30 = a20 + kstep;
            const unsigned b30 = G8_P(last ? G8_BK(nxt, 0, t3) : G8_BK(cur, 0, t3)), b31 = G8_P(last ? G8_BK(nxt, 1, t3) : G8_BK(cur, 1, t3));
            G8_LDB(B0, 0, 0); G8_LDB(B1, 0, 1); G8_SCHED; G8_LDA(At, 0, 0); G8_STAGE(G8_SA(1, 1), a1, voffA);
            G8_WAIT_V(8); G8_WAIT_L(0); G8_BAR; G8_MMA(0, 0, At, B0); G8_MMA(0, 1, At, B1); G8_BAR; G8_SCHED;
            G8_LDA(At, 0, 1); G8_STAGE(G8_SB(0, 0), b20, voffB); G8_STAGE(G8_SB(0, 1), b21, voffB); G8_STAGE(G8_SA(0, 0), a20, voffA);
            G8_WAIT_V(8); G8_WAIT_L(0); G8_BAR; G8_MMA(1, 0, At, B0); G8_MMA(1, 1, At, B1); G8_BAR; G8_SCHED;
            G8_LDB(B0, 1, 0); G8_LDB(B1, 1, 1); G8_SCHED; G8_LDA(At, 1, 0); G8_STAGE(G8_SA(0, 1), a21, voffA);
            G8_WAIT_V(8); G8_WAIT_L(0); G8_BAR; G8_MMA(0, 0, At, B0); G8_MMA(0, 1, At, B1); G8_BAR; G8_SCHED;
            G8_LDA(At, 1, 1); G8_STAGE(G8_SB(1, 0), b30, voffB); G8_STAGE(G8_SB(1, 1), b31, voffB); G8_STAGE(G8_SA(1, 0), a30, voffA);
            G8_WAIT_V(8); G8_WAIT_L(0); G8_BAR; G8_MMA(1, 0, At, B0); G8_MMA(1, 1, At, B1); G8_BAR; G8_SCHED;
        }
        if (wr == 0) G8_BAR;
        E(acc, cur, wr, wc, fr, fq);
        if (!has_next) break;
#pragma unroll
        for (int a = 0; a < 2; ++a)
#pragma unroll
            for (int b = 0; b < 2; ++b)
#pragma unroll
                for (int m = 0; m < 4; ++m)
#pragma unroll
                    for (int n = 0; n < 2; ++n) acc[a][b][m][n] = (f32x4){0.f, 0.f, 0.f, 0.f};
        cur = nxt; ++ui;
        if (wr == 1) G8_BAR;
    }
    G8_WAIT_V(0);
    G8_BAR;
#undef G8_SA
#undef G8_SB
#undef G8_STAGE
#undef G8_LDA
#undef G8_LDB
#undef G8_MMA
#undef G8_WAIT_V
#undef G8_WAIT_L
#undef G8_BAR
#undef G8_SCHED
#undef G8_BK
#undef G8_P
}
struct DenseSched {
    unsigned A, B, a_tile, b_tile; int nM, nN, G, c;
    __device__ __forceinline__ bool next(int i, Unit& u) const {
        int pm, pn; if (!tile_of(i, G, c, nM, nN, pm, pn)) return false;
        u.pm = pm; u.pn = pn; u.x0 = 0; u.x1 = 0; u.bd = 0;
        u.a0 = A + (unsigned)pm * a_tile; u.a1 = u.a0 + a_tile / 2; u.b0 = B + (unsigned)pn * b_tile; u.b1 = u.b0 + b_tile / 2; return true;
    }
};
}

__device__ __forceinline__ void convert_experts_on_idle(PP p, unsigned char* smem, int layer, int first, int mat_lo, int mat_hi) {
    const int G = gridDim.x;
    if ((int)blockIdx.x < first || first >= G) return;
    const int t_ = tid_opaque(); const int lane = t_ & 63, w = t_ >> 6;
    __syncthreads();
    float* scr = (float*)smem + w * (64 * 65);
    bf16_t* WG = (bf16_t*)(p->ws + (layer ? WS_WG1 : WS_WG0)); bf16_t* WU = (bf16_t*)(p->ws + (layer ? WS_WU1 : WS_WU0)); bf16_t* WD = (bf16_t*)(p->ws + (layer ? WS_WD1 : WS_WD0));
    for (int it = mat_lo * 2048 + ((int)blockIdx.x - first) * 8 + w; it < mat_hi * 2048; it += (G - first) * 8) convert_expert_item(p, layer, WG, WU, WD, scr, it, lane);
    __syncthreads();
}
struct EpiProj {
    static constexpr bool PERM = true;
    bf16_t* O;
    __device__ __forceinline__ void operator()(const g8::f32x4 (&acc)[2][2][4][2], const g8::Unit& u, int wr, int wc, int fr, int fq) const {
        const int row0 = u.pm * 256 + wr * 64 + fr, col0 = u.pn * 256 + wc * 32 + 8 * fq;
#pragma unroll
        for (int ai = 0; ai < 2; ++ai)
#pragma unroll
            for (int m = 0; m < 4; ++m) { bf16_t* rowp = O + (size_t)(row0 + ai * 128 + m * 16) * INW + col0;
#pragma unroll
                for (int bj = 0; bj < 2; ++bj) { const g8::f32x4 v0 = acc[ai][bj][m][0], v1 = acc[ai][bj][m][1];
                    g8::u32x4 w; w.x = g8::cvt_pk_bf16(v0[0], v0[1]); w.y = g8::cvt_pk_bf16(v0[2], v0[3]); w.z = g8::cvt_pk_bf16(v1[0], v1[1]); w.w = g8::cvt_pk_bf16(v1[2], v1[3]);
                    *(g8::u32x4*)(rowp + bj * 128) = w; } }
    }
};
__device__ __forceinline__ void convert_share(PP p, unsigned char* smem, int layer, int it0, int it1, int rk, int nblk) {
    const int t_ = tid_opaque(); const int lane = t_ & 63, w = t_ >> 6;
    __syncthreads();
    float* scr = (float*)smem + w * (64 * 65);
    bf16_t* WG = (bf16_t*)(p->ws + (layer ? WS_WG1 : WS_WG0)); bf16_t* WU = (bf16_t*)(p->ws + (layer ? WS_WU1 : WS_WU0)); bf16_t* WD = (bf16_t*)(p->ws + (layer ? WS_WD1 : WS_WD0));
    for (int it = it0 + rk * 8 + w; it < it1; it += nblk * 8) convert_expert_item(p, layer, WG, WU, WD, scr, it, lane);
    __syncthreads();
}
__device__ __forceinline__ void phase_inproj(PP p, unsigned char* smem) {
    const int b = blockIdx.x; const bool spare = b >= 16 && gridDim.x == 256, early = spare && ((b >> 3) & 1);
    const int rk = ((b >> 4) - 1) * 8 + (b & 7);
    if (early) convert_share(p, smem, 0, 0, 2048, rk, 120);
    g8::DenseSched S; S.A = (unsigned)WS_U; S.B = (unsigned)WS_WIN; S.a_tile = 256u * D * 2; S.b_tile = 256u * D * 2;
    S.nM = NTOK / 256; S.nN = INW / 256; S.G = gridDim.x; S.c = blockIdx.x;
    EpiProj E; E.O = (bf16_t*)(p->ws + WS_PROJ);
    g8::gemm_phase((LAS unsigned char*)smem, (const char*)p->ws, D, D, D, 1 << 30, S, E);
    if (spare && !early) convert_share(p, smem, 0, 2048, 4096, rk, 120);
    if (gridDim.x != 256) convert_experts_on_idle(p, smem, 0, 0, 0, 2);
}
struct EpiOut {
    static constexpr bool PERM = true;
    const float* x; const float* g1; float* out;
    __device__ __forceinline__ void operator()(const g8::f32x4 (&acc)[2][2][4][2], const g8::Unit& u, int wr, int wc, int fr, int fq) const {
        const int row0 = u.pm * 256 + wr * 64 + fr, col0 = u.pn * 256 + wc * 32 + 8 * fq;
        g8::f32x4 gv[2][2];
#pragma unroll
        for (int bj = 0; bj < 2; ++bj)
#pragma unroll
            for (int n = 0; n < 2; ++n) gv[bj][n] = *(const g8::f32x4*)(g1 + col0 + bj * 128 + n * 4);
#pragma unroll
        for (int ai = 0; ai < 2; ++ai)
#pragma unroll
            for (int m = 0; m < 4; ++m) { const size_t off = (size_t)(row0 + ai * 128 + m * 16) * D + col0;
#pragma unroll
                for (int bj = 0; bj < 2; ++bj)
#pragma unroll
                    for (int n = 0; n < 2; ++n) { const g8::f32x4 xv = *(const g8::f32x4*)(x + off + bj * 128 + n * 4);
                        *(g8::f32x4*)(out + off + bj * 128 + n * 4) = xv + gv[bj][n] * acc[ai][bj][m][n]; }
                asm volatile("" ::: "memory"); }
    }
};
__device__ __forceinline__ void phase_outproj(PP p, unsigned char* smem) {
    g8::DenseSched S; S.A = (unsigned)WS_U; S.B = (unsigned)WS_WOUT; S.a_tile = 256u * D * 2; S.b_tile = 256u * D * 2;
    S.nM = SEQ / 256; S.nN = D / 256; S.G = gridDim.x; S.c = blockIdx.x;
    EpiOut E; E.x = p->x; E.g1 = (const float*)(p->ws + WS_MOD) + 2 * 1024; E.out = p->out;
    g8::gemm_phase((LAS unsigned char*)smem, (const char*)p->ws, D, D, D, 1 << 30, S, E);
}
struct PoolSched {
    int G, c;
    __device__ __forceinline__ bool next(int i, g8::Unit& u) const {
        const int L = i * G + c; if (L >= 256) return false;
        const int pm = L >> 2, g = L & 3;
        u.pm = pm; u.pn = g; u.x0 = 0; u.x1 = 0; u.bd = 0;
        u.a0 = (unsigned)WS_HL + ((unsigned)pm * 256 * D + 256 * g) * 2; u.a1 = u.a0 + 128u * D * 2; u.b0 = (unsigned)WS_WPOOL + (unsigned)g * 65536 * 2; u.b1 = u.b0 + 128u * 256 * 2; return true;
    }
};
struct EpiPool {
    static constexpr bool PERM = true;
    const float* g1; const float* ps; float* out;
    __device__ __forceinline__ void operator()(const g8::f32x4 (&acc)[2][2][4][2], const g8::Unit& u, int wr, int wc, int fr, int fq) const {
        const int row0 = u.pm * 256 + wr * 64 + fr, col0 = u.pn * 256 + wc * 32 + 8 * fq;
        g8::f32x4 gv[2][2];
#pragma unroll
        for (int bj = 0; bj < 2; ++bj)
#pragma unroll
            for (int n = 0; n < 2; ++n) gv[bj][n] = *(const g8::f32x4*)(g1 + col0 + bj * 128 + n * 4) * *(const g8::f32x4*)(ps + col0 + bj * 128 + n * 4);
#pragma unroll
        for (int ai = 0; ai < 2; ++ai)
#pragma unroll
            for (int m = 0; m < 4; ++m) { const size_t off = (size_t)(row0 + ai * 128 + m * 16) * D + col0;
#pragma unroll
                for (int bj = 0; bj < 2; ++bj)
#pragma unroll
                    for (int n = 0; n < 2; ++n) { g8::f32x4* op = (g8::f32x4*)(out + off + bj * 128 + n * 4); const g8::f32x4 hv = *op;
                        *op = hv + gv[bj][n] * acc[ai][bj][m][n]; }
                asm volatile("" ::: "memory"); }
    }
};
__device__ __forceinline__ void phase_poolgemm(PP p, unsigned char* smem) {
    PoolSched S; S.G = gridDim.x; S.c = blockIdx.x;
    EpiPool E; E.g1 = (const float*)(p->ws + WS_MOD) + 2 * 6144 + 2 * 1024; E.ps = p->pool_scale; E.out = p->out;
    g8::gemm_phase((LAS unsigned char*)smem, (const char*)p->ws, 256, D, 256, 1 << 30, S, E);
}

__device__ __forceinline__ int scan_row(int d, int pos) { return d == 0 ? pos : (pos < CTXL ? (CTXL - 1 - pos) : (CTXL + SEQ - 1 - (pos - CTXL))); }
__device__ __forceinline__ float lb_of(PP p, int d, int kw) { return sigmoidf_(p->lb_logits[1024 + d * 512 + kw] - p->lb_logits[d * 512 + kw]); }

constexpr int HG_QT = 0;
constexpr int HG_KT = 17408;
constexpr int HG_QS = 34816;
constexpr int HG_KE = 52224;
constexpr int HG_VT = 70656;
constexpr int HG_ST = 89088;
constexpr int HG_SEG = 123904;
constexpr int HG_DV = 125952;
typedef float f32x4v __attribute__((ext_vector_type(4)));
struct GateRaw { unsigned f[16], v[16], q[16]; };
template <bool FULL>
__device__ __forceinline__ void hgrn_gates_load(PP p, int d, int h, int pos0, int t, GateRaw& R) {
    const int k = t & 127, qd = t >> 7;
    const bf16_t* PROJ = (const bf16_t*)(p->ws + WS_PROJ);
#pragma unroll
    for (int i = 0; i < 16; ++i) {
        const int row = scan_row(d, pos0 + 16 * qd + i);
        const bf16_t* pr = PROJ + (size_t)row * INW + 128 * h + k;
        R.f[i] = pr[512 + 512 * d]; R.v[i] = pr[1536];
        if (FULL) R.q[i] = pr[0]; else R.q[i] = 0u;
    }
}
__device__ __forceinline__ void gate_raw_pin(GateRaw& R) {
#define PIN16(a) asm volatile("" : "+v"(a[0]), "+v"(a[1]), "+v"(a[2]), "+v"(a[3]), "+v"(a[4]), "+v"(a[5]), "+v"(a[6]), "+v"(a[7]), "+v"(a[8]), "+v"(a[9]), "+v"(a[10]), "+v"(a[11]), "+v"(a[12]), "+v"(a[13]), "+v"(a[14]), "+v"(a[15]))
    PIN16(R.f); PIN16(R.v); PIN16(R.q);
#undef PIN16
}
template <bool FULL>
__device__ __forceinline__ float hgrn_gates_compute(unsigned char* smem, const GateRaw& R, float lbv, int t) {
    const int k = t & 127, qd = t >> 7;
    float* seg = (float*)(smem + HG_SEG); float* Dv = (float*)(smem + HG_DV);
    float a[16], kk[16];
    const float L2E = 1.4426950408889634f;
#pragma unroll
    for (int i = 0; i < 16; ++i) {
        const float sg = __builtin_amdgcn_rcpf(1.0f + __builtin_amdgcn_exp2f(-L2E * bf2f(R.f[i])));
        const float f = lbv + (1.f - lbv) * sg;
        a[i] = __builtin_amdgcn_logf(f); kk[i] = 1.f - f;
    }
#pragma unroll
    for (int i = 1; i < 16; ++i) a[i] += a[i - 1];
    seg[qd * 128 + k] = a[15];
    __syncthreads();
    const float s0 = seg[k], s1 = seg[128 + k], s2 = seg[256 + k], s3 = seg[384 + k];
    const float off = qd == 0 ? 0.f : qd == 1 ? s0 : qd == 2 ? (s0 + s1) : (s0 + s1 + s2);
    const float bref = s0 + s1, btot = (s0 + s1) + (s2 + s3);
    const float dtot = __builtin_amdgcn_exp2f(btot);
    if (qd == 0) Dv[k] = dtot;
    unsigned kew[8], vw[8];
    bf16_t* QT = (bf16_t*)(smem + HG_QT); bf16_t* KT = (bf16_t*)(smem + HG_KT); bf16_t* QS = (bf16_t*)(smem + HG_QS);
    const float qscale = 0.08838834764831845f;
#pragma unroll
    for (int i = 0; i < 16; i += 2) {
        const float b0 = off + a[i], b1 = off + a[i + 1];
        kew[i >> 1] = g8::cvt_pk_bf16(kk[i] * __builtin_amdgcn_exp2f(btot - b0), kk[i + 1] * __builtin_amdgcn_exp2f(btot - b1));
        vw[i >> 1] = R.v[i] | (R.v[i + 1] << 16);
        if (FULL) {
            const float e0 = fminf(fmaxf(b0 - bref, -110.f), 110.f), e1 = fminf(fmaxf(b1 - bref, -110.f), 110.f);
            const float E0 = __builtin_amdgcn_exp2f(e0), E1 = __builtin_amdgcn_exp2f(e1);
            const float q0 = bf2f(R.q[i]) * qscale, q1 = bf2f(R.q[i + 1]) * qscale;
            const unsigned wq = g8::cvt_pk_bf16(q0 * E0, q1 * E1);
            const unsigned wk = g8::cvt_pk_bf16(kk[i] * __builtin_amdgcn_rcpf(E0), kk[i + 1] * __builtin_amdgcn_rcpf(E1));
            const unsigned ws_ = g8::cvt_pk_bf16(q0 * __builtin_amdgcn_exp2f(b0), q1 * __builtin_amdgcn_exp2f(b1));
            const int r0 = (16 * qd + i) * 136 + k, r1 = r0 + 136;
            QT[r0] = (bf16_t)(wq & 0xffffu); QT[r1] = (bf16_t)(wq >> 16);
            KT[r0] = (bf16_t)(wk & 0xffffu); KT[r1] = (bf16_t)(wk >> 16);
            QS[r0] = (bf16_t)(ws_ & 0xffffu); QS[r1] = (bf16_t)(ws_ >> 16);
        }
    }
    uint4* ke = (uint4*)(smem + HG_KE + k * 144 + qd * 32); uint4* vt = (uint4*)(smem + HG_VT + k * 144 + qd * 32);
    ke[0] = make_uint4(kew[0], kew[1], kew[2], kew[3]); ke[1] = make_uint4(kew[4], kew[5], kew[6], kew[7]);
    vt[0] = make_uint4(vw[0], vw[1], vw[2], vw[3]); vt[1] = make_uint4(vw[4], vw[5], vw[6], vw[7]);
    return dtot;
}
__device__ __forceinline__ void hgrn_state_update(unsigned char* smem, f32x16 (&sacc)[2], int w, int lane) {
    const int r = lane & 31, hh = lane >> 5, vt = w & 3;
    const float* Dv = (const float*)(smem + HG_DV);
#pragma unroll
    for (int kt2 = 0; kt2 < 2; ++kt2) {
        const int kt = 2 * (w >> 2) + kt2;
#pragma unroll
        for (int g = 0; g < 4; ++g) {
            const f32x4v dv = *(const f32x4v*)(Dv + 32 * kt + 8 * g + 4 * hh);
            sacc[kt2][4 * g + 0] *= dv[0]; sacc[kt2][4 * g + 1] *= dv[1]; sacc[kt2][4 * g + 2] *= dv[2]; sacc[kt2][4 * g + 3] *= dv[3];
        }
        {
            bf16x8 ao[4], bo[4];
#pragma unroll
            for (int js = 0; js < 4; ++js) {
                ao[js] = *(const bf16x8*)(smem + HG_KE + (32 * kt + r) * 144 + (16 * js + 8 * hh) * 2);
                bo[js] = *(const bf16x8*)(smem + HG_VT + (32 * vt + r) * 144 + (16 * js + 8 * hh) * 2);
            }
            __builtin_amdgcn_sched_barrier(0);
#pragma unroll
            for (int js = 0; js < 4; ++js) sacc[kt2] = __builtin_amdgcn_mfma_f32_32x32x16_bf16(ao[js], bo[js], sacc[kt2], 0, 0, 0);
        }
    }
}
__device__ __forceinline__ void hgrn_passA_unit(PP p, unsigned char* smem, int u) {
    const int d = u >> 8, h = (u >> 6) & 3, c = u & 63;
    const int t = tid_opaque(), lane = t & 63, w = t >> 6;
    const float lbv = lb_of(p, d, 128 * h + (t & 127));
    f32x16 sacc[2];
#pragma unroll
    for (int i = 0; i < 16; ++i) { sacc[0][i] = 0.f; sacc[1][i] = 0.f; }
    float Dtot = 1.f;
    GateRaw R;
    hgrn_gates_load<false>(p, d, h, 256 * c, t, R);
    for (int sub = 0; sub < 4; ++sub) {
        gate_raw_pin(R);
        Dtot *= hgrn_gates_compute<false>(smem, R, lbv, t);
        if (sub < 3) hgrn_gates_load<false>(p, d, h, 256 * c + 64 * (sub + 1), t, R);
        __syncthreads();
        hgrn_state_update(smem, sacc, w, lane);
    }
    float* L = (float*)(p->ws + WS_HL) + (size_t)u * 16384;
    const int r = lane & 31, hh = lane >> 5, vt = w & 3;
#pragma unroll
    for (int kt2 = 0; kt2 < 2; ++kt2)
#pragma unroll
        for (int e = 0; e < 16; ++e) L[(32 * (2 * (w >> 2) + kt2) + (e & 3) + 8 * (e >> 2) + 4 * hh) * 128 + 32 * vt + r] = sacc[kt2][e];
    if (t < 128) ((float*)(p->ws + WS_HD))[(size_t)u * 128 + t] = Dtot;
    __syncthreads();
}
__device__ __forceinline__ void phase_hgrnB(PP p) {
    const float* __restrict__ L = (const float*)(p->ws + WS_HL); const float* __restrict__ Dd = (const float*)(p->ws + WS_HD); float* __restrict__ SST = (float*)(p->ws + WS_HS);
    const int t_ = tid_opaque();
    for (int e = blockIdx.x * NTHREADS + t_; e < 8 * 16384; e += gridDim.x * NTHREADS) {
        const int dh = e >> 14, kv = e & 16383, k = kv >> 7;
        float S = 0.f;
        for (int c0 = 0; c0 < 64; c0 += 16) {
            float lv[16], dv[16];
#pragma unroll
            for (int c = 0; c < 16; ++c) { const size_t ui = (size_t)dh * 64 + c0 + c; lv[c] = L[ui * 16384 + kv]; dv[c] = Dd[ui * 128 + k]; }
#pragma unroll
            for (int c = 0; c < 16; ++c) { const size_t ui = (size_t)dh * 64 + c0 + c; S = dv[c] * S + lv[c]; SST[ui * 16384 + kv] = S; }
        }
    }
}
__device__ __forceinline__ void hgrn_passC_unit(PP p, unsigned char* smem, int u) {
    const int h = u >> 6, jb = u & 63;
    const int t = tid_opaque(), lane = t & 63, w = t >> 6, r = lane & 31, hh = lane >> 5, vt = w & 3, it = w >> 2;
    const bf16_t* PROJ = (const bf16_t*)(p->ws + WS_PROJ);
    float* OSF = (float*)(p->ws + WS_HL) + ((size_t)h * SEQ + 256 * jb) * 128;
    float* OSB = p->out + ((size_t)h * SEQ + 256 * jb) * 128;
    const float lb0 = lb_of(p, 0, 128 * h + (t & 127)), lb1 = lb_of(p, 1, 128 * h + (t & 127));
    GateRaw R;
    hgrn_gates_load<true>(p, 0, h, 256 * (1 + jb), t, R);
    f32x16 sacc[2];
    for (int step = 0; step < 8; ++step) {
        const int d = step >> 2, sub = step & 3;
        const int cs = (d == 0) ? (1 + jb) : (64 - jb);
        if (sub == 0) {
            const float* S0 = (const float*)(p->ws + WS_HS) + ((size_t)(d * 4 + h) * 64 + (cs - 1)) * 16384;
#pragma unroll
            for (int kt2 = 0; kt2 < 2; ++kt2)
#pragma unroll
                for (int e = 0; e < 16; ++e) sacc[kt2][e] = S0[(32 * (2 * it + kt2) + (e & 3) + 8 * (e >> 2) + 4 * hh) * 128 + 32 * vt + r];
        }
#pragma unroll
        for (int kt2 = 0; kt2 < 2; ++kt2)
#pragma unroll
            for (int g = 0; g < 4; ++g) {
                uint2 o; o.x = g8::cvt_pk_bf16(sacc[kt2][4 * g + 0], sacc[kt2][4 * g + 1]); o.y = g8::cvt_pk_bf16(sacc[kt2][4 * g + 2], sacc[kt2][4 * g + 3]);
                *(uint2*)(smem + HG_ST + (32 * vt + r) * 272 + (32 * (2 * it + kt2) + 8 * g + 4 * hh) * 2) = o;
            }
        gate_raw_pin(R);
        (void)hgrn_gates_compute<true>(smem, R, d ? lb1 : lb0, t);
        if (step < 7) { const int d2 = (step + 1) >> 2, sub2 = (step + 1) & 3; hgrn_gates_load<true>(p, d2, h, 256 * (d2 == 0 ? (1 + jb) : (64 - jb)) + 64 * sub2, t, R); }
        __syncthreads();
        f32x16 o;
#pragma unroll
        for (int e = 0; e < 16; ++e) o[e] = 0.f;
#pragma unroll
        for (int jt = 0; jt < 2; ++jt) {
            if (jt <= it) {
                f32x16 sT;
#pragma unroll
                for (int e = 0; e < 16; ++e) sT[e] = 0.f;
                {
                    bf16x8 ao[8], bo[8];
#pragma unroll
                    for (int ks = 0; ks < 8; ++ks) {
                        ao[ks] = *(const bf16x8*)(smem + HG_KT + (32 * jt + r) * 272 + (16 * ks + 8 * hh) * 2);
                        bo[ks] = *(const bf16x8*)(smem + HG_QT + (32 * it + r) * 272 + (16 * ks + 8 * hh) * 2);
                    }
                    __builtin_amdgcn_sched_barrier(0);
#pragma unroll
                    for (int ks = 0; ks < 8; ++ks) sT = __builtin_amdgcn_mfma_f32_32x32x16_bf16(ao[ks], bo[ks], sT, 0, 0, 0);
                }
                if (jt == it) {
#pragma unroll
                    for (int e = 0; e < 16; ++e) { const int j = (e & 3) + 8 * (e >> 2) + 4 * hh; sT[e] = (j <= r) ? sT[e] : 0.f; }
                }
#pragma unroll
                for (int s = 0; s < 2; ++s) {
                    bf16x8 pa;
                    const unsigned w0 = g8::cvt_pk_bf16(sT[8 * s + 0], sT[8 * s + 1]), w1 = g8::cvt_pk_bf16(sT[8 * s + 2], sT[8 * s + 3]), w2 = g8::cvt_pk_bf16(sT[8 * s + 4], sT[8 * s + 5]), w3 = g8::cvt_pk_bf16(sT[8 * s + 6], sT[8 * s + 7]);
                    pa[0] = (short)(w0 & 0xffff); pa[1] = (short)(w0 >> 16); pa[2] = (short)(w1 & 0xffff); pa[3] = (short)(w1 >> 16);
                    pa[4] = (short)(w2 & 0xffff); pa[5] = (short)(w2 >> 16); pa[6] = (short)(w3 & 0xffff); pa[7] = (short)(w3 >> 16);
                    const uint2 v0 = *(const uint2*)(smem + HG_VT + (32 * vt + r) * 144 + (32 * jt + 16 * s + 4 * hh) * 2);
                    const uint2 v1 = *(const uint2*)(smem + HG_VT + (32 * vt + r) * 144 + (32 * jt + 16 * s + 8 + 4 * hh) * 2);
                    bf16x8 vb;
                    vb[0] = (short)(v0.x & 0xffff); vb[1] = (short)(v0.x >> 16); vb[2] = (short)(v0.y & 0xffff); vb[3] = (short)(v0.y >> 16);
                    vb[4] = (short)(v1.x & 0xffff); vb[5] = (short)(v1.x >> 16); vb[6] = (short)(v1.y & 0xffff); vb[7] = (short)(v1.y >> 16);
                    o = __builtin_amdgcn_mfma_f32_32x32x16_bf16(pa, vb, o, 0, 0, 0);
                }
            }
        }
        {
            bf16x8 ao[8], bo[8];
#pragma unroll
            for (int ks = 0; ks < 8; ++ks) {
                ao[ks] = *(const bf16x8*)(smem + HG_QS + (32 * it + r) * 272 + (16 * ks + 8 * hh) * 2);
                bo[ks] = *(const bf16x8*)(smem + HG_ST + (32 * vt + r) * 272 + (16 * ks + 8 * hh) * 2);
            }
            __builtin_amdgcn_sched_barrier(0);
#pragma unroll
            for (int ks = 0; ks < 8; ++ks) o = __builtin_amdgcn_mfma_f32_32x32x16_bf16(ao[ks], bo[ks], o, 0, 0, 0);
        }
        {
            float* OS = d ? OSB : OSF;
#pragma unroll
            for (int e = 0; e < 16; ++e) {
                const int pos = 64 * sub + 32 * it + (e & 3) + 8 * (e >> 2) + 4 * hh;
                const int tl = (d == 0) ? pos : (255 - pos);
                OS[tl * 128 + 32 * vt + r] = o[e];
            }
        }
        hgrn_state_update(smem, sacc, w, lane);
        __syncthreads();
    }
    __syncthreads();
    bf16_t* AB = (bf16_t*)(p->ws + WS_U);
    const float ng0 = p->a_norm_g[128 * h + lane], ng1 = p->a_norm_g[128 * h + 64 + lane];
    for (int tb = 0; tb < 4; ++tb) {
        float o0[8], o1[8], g0[8], g1[8];
#pragma unroll
        for (int q = 0; q < 8; ++q) {
            const int tl = w * 32 + tb * 8 + q;
            o0[q] = OSF[tl * 128 + lane] + OSB[tl * 128 + lane]; o1[q] = OSF[tl * 128 + 64 + lane] + OSB[tl * 128 + 64 + lane];
            const bf16_t* pr = PROJ + (size_t)(CTXL + 256 * jb + tl) * INW + 2048 + 128 * h;
            g0[q] = bf2f(pr[lane]); g1[q] = bf2f(pr[64 + lane]);
        }
        float ss[8];
#pragma unroll
        for (int q = 0; q < 8; ++q) ss[q] = o0[q] * o0[q] + o1[q] * o1[q];
#pragma unroll
        for (int m = 1; m < 64; m <<= 1) {
#pragma unroll
            for (int q = 0; q < 8; ++q) ss[q] += __shfl_xor(ss[q], m);
        }
#pragma unroll
        for (int q = 0; q < 8; ++q) {
            const int tok = 256 * jb + w * 32 + tb * 8 + q;
            const float rr = rsqrtf(ss[q] * (1.0f / 128.0f) + EPS);
            AB[(size_t)tok * D + 128 * h + lane] = (bf16_t)f2bf(o0[q] * rr * ng0 * silu_fast(g0[q]));
            AB[(size_t)tok * D + 128 * h + 64 + lane] = (bf16_t)f2bf(o1[q] * rr * ng1 * silu_fast(g1[q]));
        }
    }
    __syncthreads();
}

constexpr int AT_VW = 0;
constexpr int AT_VC = 73728;
constexpr int AT_BS = 106496;
constexpr int AT_MG = 0;
typedef unsigned short u16x4 __attribute__((ext_vector_type(4)));
#define AT_TRREAD4(a0, a1, b0, b1, addr) asm volatile("ds_read_b64_tr_b16 %0, %4\n\tds_read_b64_tr_b16 %1, %4 offset:1024\n\tds_read_b64_tr_b16 %2, %4 offset:64\n\tds_read_b64_tr_b16 %3, %4 offset:1088\n\ts_waitcnt lgkmcnt(0)" \
    : "=&v"(a0), "=&v"(a1), "=&v"(b0), "=&v"(b1) : "v"(addr) : "memory")
__device__ __forceinline__ void attn_unit(PP p, unsigned char* smem, int u) {
    const int h = u >> 7, bb = u & 127, rp = (bb & 7) * 16 + (bb >> 3), r0 = 2 * rp;
    const int t = tid_opaque(), lane = t & 63, w = __builtin_amdgcn_readfirstlane(t >> 6), qt = w & 3, part = w >> 2, ql = lane & 31, hh = lane >> 5;
    const bf16_t* PROJ = (const bf16_t*)(p->ws + WS_PROJ);
    float* bS = (float*)(smem + AT_BS);
    const int krb = min(max(r0 - 4, 0), 248);
    __syncthreads();
#pragma unroll
    for (int i = 0; i < 9; ++i) {
        const int e = t + 512 * i, key = e >> 3, piece = e & 7;
        const int tok = min(krb + (key >> 6), 255) * 64 + (key & 63);
        *(uint4*)(smem + AT_VW + key * 128 + piece * 16) = *(const uint4*)(PROJ + (size_t)(CTXL + tok) * INW + 3584 + 64 * h + 8 * piece);
    }
#pragma unroll
    for (int i = 0; i < 4; ++i) {
        const int e = t + 512 * i, key = e >> 3, piece = e & 7;
        *(uint4*)(smem + AT_VC + key * 128 + piece * 16) = *(const uint4*)(PROJ + (size_t)key * INW + 3584 + 64 * h + 8 * piece);
    }
    if (t < 465) bS[t] = p->rpb[h * 465 + t] * 1.4426950408889634f;
    const int qr = r0 + (ql >> 4), qcol = 16 * qt + (ql & 15);
    bf16x8 qf[4];
    {
        const bf16_t* qp = PROJ + (size_t)(CTXL + qr * 64 + qcol) * INW + 2560 + 64 * h + 8 * hh;
#pragma unroll
        for (int s = 0; s < 4; ++s) {
            const uint4 qv = *(const uint4*)(qp + 16 * s);
            const float qs_ = 0.125f * 1.4426950408889634f;
            const unsigned w0 = pk2(bflo(qv.x) * qs_, bfhi(qv.x) * qs_), w1 = pk2(bflo(qv.y) * qs_, bfhi(qv.y) * qs_);
            const unsigned w2 = pk2(bflo(qv.z) * qs_, bfhi(qv.z) * qs_), w3 = pk2(bflo(qv.w) * qs_, bfhi(qv.w) * qs_);
            qf[s][0] = (short)(w0 & 0xffff); qf[s][1] = (short)(w0 >> 16); qf[s][2] = (short)(w1 & 0xffff); qf[s][3] = (short)(w1 >> 16);
            qf[s][4] = (short)(w2 & 0xffff); qf[s][5] = (short)(w2 >> 16); qf[s][6] = (short)(w3 & 0xffff); qf[s][7] = (short)(w3 >> 16);
        }
    }
    const int kcs = min(max(16 * qt - 8, 0), 32);
    const int krq = min(max(qr - 4, 0), 248), kc0q = min(max(qcol - 8, 0), 48);
    unsigned cmask = 0u;
#pragma unroll
    for (int e = 0; e < 16; ++e) { const int kc = kcs + (e & 3) + 8 * (e >> 2) + 4 * hh; cmask |= ((unsigned)(kc - kc0q) < 16u) ? (1u << e) : 0u; }
    const int dcb = kcs + 4 * hh - qcol + 15;
    auto loadK = [&](int ti, uint4 (&kf)[4]) {
        int row;
        if (ti < 9) row = CTXL + min(krb + ti, 255) * 64 + kcs + ql; else row = 32 * (ti - 9) + ql;
        const bf16_t* kp = PROJ + (size_t)row * INW + 3072 + 64 * h + 8 * hh;
#pragma unroll
        for (int s = 0; s < 4; ++s) kf[s] = *(const uint4*)(kp + 16 * s);
    };
    const int tb = part ? 6 : 0, te = part ? 17 : 6;
    float mrun = -1e30f, lrun = 0.f;
    f32x16 oT[2];
#pragma unroll
    for (int e = 0; e < 16; ++e) { oT[0][e] = 0.f; oT[1][e] = 0.f; }
    auto scores = [&](int ti, const uint4 (&kf)[4], float (&sc)[16]) {
        f32x16 sT;
#pragma unroll
        for (int e = 0; e < 16; ++e) sT[e] = 0.f;
#pragma unroll
        for (int s = 0; s < 4; ++s) {
            bf16x8 ka;
            ka[0] = (short)(kf[s].x & 0xffff); ka[1] = (short)(kf[s].x >> 16); ka[2] = (short)(kf[s].y & 0xffff); ka[3] = (short)(kf[s].y >> 16);
            ka[4] = (short)(kf[s].z & 0xffff); ka[5] = (short)(kf[s].z >> 16); ka[6] = (short)(kf[s].w & 0xffff); ka[7] = (short)(kf[s].w >> 16);
            sT = __builtin_amdgcn_mfma_f32_32x32x16_bf16(ka, qf[s], sT, 0, 0, 0);
        }
        if (ti < 9) {
            const int kr = krb + ti;
            const bool rv = (kr >= krq) && (kr < krq + 8) && (kr < 256);
            const unsigned okm = rv ? cmask : 0u;
            const float* brow = bS + min(max((kr - qr + 7), 0), 14) * 31 + dcb;
            float bv[16];
#pragma unroll
            for (int e = 0; e < 16; ++e) bv[e] = brow[(e & 3) + 8 * (e >> 2)];
#pragma unroll
            for (int e = 0; e < 16; ++e) sc[e] = ((okm >> e) & 1u) ? (sT[e] + bv[e]) : -3e38f;
        } else if (ti < 17) {
#pragma unroll
            for (int e = 0; e < 16; ++e) sc[e] = sT[e];
        } else {
#pragma unroll
            for (int e = 0; e < 16; ++e) sc[e] = -3e38f;
        }
    };
    auto v_issue = [&](int ti, u16x4 (&vf)[8]) {
        const int tic = min(ti, 16);
        const int vbase = (tic < 9) ? (AT_VW + (tic * 64 + kcs) * 128) : (AT_VC + (32 * (tic - 9)) * 128);
        const unsigned va = (unsigned)(vbase + (4 * hh + ((lane & 15) >> 2)) * 128 + (16 * ((lane >> 4) & 1) + 4 * (lane & 3)) * 2);
        asm volatile("ds_read_b64_tr_b16 %0, %8\n\tds_read_b64_tr_b16 %1, %8 offset:1024\n\tds_read_b64_tr_b16 %2, %8 offset:64\n\tds_read_b64_tr_b16 %3, %8 offset:1088\n\t"
                     "ds_read_b64_tr_b16 %4, %8 offset:2048\n\tds_read_b64_tr_b16 %5, %8 offset:3072\n\tds_read_b64_tr_b16 %6, %8 offset:2112\n\tds_read_b64_tr_b16 %7, %8 offset:3136"
                     : "=&v"(vf[0]), "=&v"(vf[1]), "=&v"(vf[2]), "=&v"(vf[3]), "=&v"(vf[4]), "=&v"(vf[5]), "=&v"(vf[6]), "=&v"(vf[7]) : "v"(va) : "memory");
    };
    auto v_wait = [&](u16x4 (&va)[8], u16x4 (&vb)[8]) {
        asm volatile("s_waitcnt lgkmcnt(0)" : "+v"(va[0]), "+v"(va[1]), "+v"(va[2]), "+v"(va[3]), "+v"(va[4]), "+v"(va[5]), "+v"(va[6]), "+v"(va[7]),
                                               "+v"(vb[0]), "+v"(vb[1]), "+v"(vb[2]), "+v"(vb[3]), "+v"(vb[4]), "+v"(vb[5]), "+v"(vb[6]), "+v"(vb[7]) :: "memory");
    };
    auto pv_acc = [&](const u16x4 (&vf)[8], const float (&pv)[16]) {
#pragma unroll
        for (int s2 = 0; s2 < 2; ++s2) {
            const u16x4 a0 = vf[4 * s2 + 0], a1 = vf[4 * s2 + 1], b0 = vf[4 * s2 + 2], b1 = vf[4 * s2 + 3];
            bf16x8 va0, va1, pb;
            va0[0] = (short)a0[0]; va0[1] = (short)a0[1]; va0[2] = (short)a0[2]; va0[3] = (short)a0[3]; va0[4] = (short)a1[0]; va0[5] = (short)a1[1]; va0[6] = (short)a1[2]; va0[7] = (short)a1[3];
            va1[0] = (short)b0[0]; va1[1] = (short)b0[1]; va1[2] = (short)b0[2]; va1[3] = (short)b0[3]; va1[4] = (short)b1[0]; va1[5] = (short)b1[1]; va1[6] = (short)b1[2]; va1[7] = (short)b1[3];
            const unsigned w0 = g8::cvt_pk_bf16(pv[8 * s2 + 0], pv[8 * s2 + 1]), w1 = g8::cvt_pk_bf16(pv[8 * s2 + 2], pv[8 * s2 + 3]), w2 = g8::cvt_pk_bf16(pv[8 * s2 + 4], pv[8 * s2 + 5]), w3 = g8::cvt_pk_bf16(pv[8 * s2 + 6], pv[8 * s2 + 7]);
            pb[0] = (short)(w0 & 0xffff); pb[1] = (short)(w0 >> 16); pb[2] = (short)(w1 & 0xffff); pb[3] = (short)(w1 >> 16);
            pb[4] = (short)(w2 & 0xffff); pb[5] = (short)(w2 >> 16); pb[6] = (short)(w3 & 0xffff); pb[7] = (short)(w3 >> 16);
            oT[0] = __builtin_amdgcn_mfma_f32_32x32x16_bf16(va0, pb, oT[0], 0, 0, 0);
            oT[1] = __builtin_amdgcn_mfma_f32_32x32x16_bf16(va1, pb, oT[1], 0, 0, 0);
        }
    };
    auto pair = [&](int ti0, const uint4 (&k0)[4], const uint4 (&k1)[4]) {
        float s0[16], s1[16];
        u16x4 vfa[8], vfb[8];
        v_issue(ti0, vfa); v_issue(ti0 + 1, vfb);
        scores(ti0, k0, s0); scores(ti0 + 1, k1, s1);
        float mt = fmaxf(s0[0], s1[0]);
#pragma unroll
        for (int e = 1; e < 16; ++e) mt = fmaxf(mt, fmaxf(s0[e], s1[e]));
        mt = fmaxf(mt, __shfl_xor(mt, 32));
        const float mn = fmaxf(mrun, mt), corr = __builtin_amdgcn_exp2f(mrun - mn);
        const bool grew = mn > mrun;
        mrun = mn;
        float ls = 0.f;
#pragma unroll
        for (int e = 0; e < 16; ++e) {
            s0[e] = __builtin_amdgcn_exp2f(s0[e] - mn);
            s1[e] = __builtin_amdgcn_exp2f(s1[e] - mn);
            ls += s0[e] + s1[e];
        }
        ls += __shfl_xor(ls, 32);
        lrun = lrun * corr + ls;
        if (__any(grew)) {
#pragma unroll
            for (int e = 0; e < 16; ++e) { oT[0][e] *= corr; oT[1][e] *= corr; }
        }
        v_wait(vfa, vfb);
        pv_acc(vfa, s0); pv_acc(vfb, s1);
    };
    const int te2 = part ? 18 : 6;
    uint4 kA[2][4], kB[2][4];
#pragma unroll
    for (int j = 0; j < 2; ++j) loadK(min(tb + j, 16), kA[j]);
    __syncthreads();
    for (int g0 = tb; g0 < te2; g0 += 4) {
#pragma unroll
        for (int j = 0; j < 2; ++j) loadK(min(g0 + 2 + j, 16), kB[j]);
        pair(g0, kA[0], kA[1]);
#pragma unroll
        for (int j = 0; j < 2; ++j) loadK(min(g0 + 4 + j, 16), kA[j]);
        if (g0 + 2 < te2) pair(g0 + 2, kB[0], kB[1]);
    }
    __syncthreads();
    float* mg = (float*)(smem + AT_MG) + qt * 34 * 64;
    if (part == 1) {
        mg[0 * 64 + lane] = mrun; mg[1 * 64 + lane] = lrun;
#pragma unroll
        for (int e = 0; e < 16; ++e) { mg[(2 + e) * 64 + lane] = oT[0][e]; mg[(18 + e) * 64 + lane] = oT[1][e]; }
    }
    __syncthreads();
    if (part == 0) {
        const float m2 = mg[lane], l2 = mg[64 + lane];
        const float mn = fmaxf(mrun, m2), a1 = __builtin_amdgcn_exp2f(mrun - mn), a2 = __builtin_amdgcn_exp2f(m2 - mn);
        const float inv = 1.0f / (lrun * a1 + l2 * a2);
        bf16_t* op = (bf16_t*)(p->ws + WS_U) + (size_t)(qr * 64 + qcol) * D + 512 + 64 * h + 4 * hh;
#pragma unroll
        for (int dt = 0; dt < 2; ++dt)
#pragma unroll
            for (int g = 0; g < 4; ++g) {
                float o4[4];
#pragma unroll
                for (int j = 0; j < 4; ++j) o4[j] = (oT[dt][4 * g + j] * a1 + mg[(2 + 16 * dt + 4 * g + j) * 64 + lane] * a2) * inv;
                uint2 o; o.x = pk2(o4[0], o4[1]); o.y = pk2(o4[2], o4[3]);
                *(uint2*)(op + 32 * dt + 8 * g) = o;
            }
    }
}
__device__ __forceinline__ void phase_mix3(PP p, unsigned char* smem) {
    for (int u = blockIdx.x; u < 512 + 1024; u += gridDim.x) {
        if (u < 512) hgrn_passA_unit(p, smem, u); else attn_unit(p, smem, u - 512);
    }
}
__device__ __forceinline__ void phase_hgrnC(PP p, unsigned char* smem) {
    for (int u = blockIdx.x; u < 256; u += gridDim.x) hgrn_passC_unit(p, smem, u);
}

constexpr int MOE_TAB_OFF = 143360;
constexpr int CHUNK_TOK = 64;
__device__ __forceinline__ void class_experts(int cls, int& ea, int& eb) {
    const int grp = cls / 6, pi = cls % 6;
    const int la = pi < 3 ? 0 : (pi < 5 ? 1 : 2), lb = pi < 3 ? pi + 1 : (pi < 5 ? pi - 1 : 3);
    ea = grp * 4 + la; eb = grp * 4 + lb;
}
__device__ __forceinline__ void moe_norm_row(const float* hrow, const float* g, const float* sh, const float* scl, float4 (&v)[4], int lane) {
    float s = 0.f;
#pragma unroll
    for (int j = 0; j < 4; ++j) { v[j] = ((const float4*)hrow)[lane + 64 * j]; s += (v[j].x * v[j].x + v[j].y * v[j].y) + (v[j].z * v[j].z + v[j].w * v[j].w); }
    const float rstd = rsqrtf(wave_sum(s) * (1.0f / D) + EPS);
#pragma unroll
    for (int j = 0; j < 4; ++j) {
        const int c4 = lane + 64 * j;
        const float4 gg = ((const float4*)g)[c4], s4 = ((const float4*)sh)[c4], c4v = ((const float4*)scl)[c4];
        v[j].x = v[j].x * rstd * gg.x * (1.f + c4v.x) + s4.x; v[j].y = v[j].y * rstd * gg.y * (1.f + c4v.y) + s4.y;
        v[j].z = v[j].z * rstd * gg.z * (1.f + c4v.z) + s4.z; v[j].w = v[j].w * rstd * gg.w * (1.f + c4v.w) + s4.w;
    }
}
constexpr int WRT_LD = 1028;
__device__ __forceinline__ void phase_route1(PP p, unsigned char* smem, int layer) {
    const int t = tid_opaque(), lane = t & 63, w = t >> 6;
    float* wrT = (float*)smem;
    int* bc = (int*)(smem + 16 * WRT_LD * 4);
    float* sx = (float*)(smem + 16 * WRT_LD * 4 + 256);
    const int tokw = blockIdx.x * CHUNK_TOK + w * 8;
    float4 v[4][4];
#pragma unroll
    for (int q = 0; q < 4; ++q)
#pragma unroll
        for (int j = 0; j < 4; ++j) v[q][j] = ((const float4*)(p->out + (size_t)(tokw + q) * D))[lane + 64 * j];
    {
        float4 wv[8];
#pragma unroll
        for (int q = 0; q < 8; ++q) wv[q] = ((const float4*)p->w_router)[t + NTHREADS * q];
#pragma unroll
        for (int q = 0; q < 8; ++q) {
            const int i = t + NTHREADS * q, c = i >> 2, e4 = (i & 3) * 4;
            wrT[(e4 + 0) * WRT_LD + c] = wv[q].x; wrT[(e4 + 1) * WRT_LD + c] = wv[q].y; wrT[(e4 + 2) * WRT_LD + c] = wv[q].z; wrT[(e4 + 3) * WRT_LD + c] = wv[q].w;
        }
    }
    if (t < 32) bc[t] = 0;
    __syncthreads();
    const float* modv = (const float*)(p->ws + WS_MOD) + (layer ? 2 * 6144 : 0);
    const float* sh = modv + 3 * 1024; const float* scl = modv + 4 * 1024; const float* g = p->norm2_g + layer * D;
    float4* tokinfo = (float4*)(p->ws + WS_TOKINFO);
    bf16_t* U2T = (bf16_t*)(p->ws + WS_U);
    const float brt = p->b_router[lane & 15];
    for (int bt = 0; bt < 2; ++bt) {
        const int tok0 = tokw + bt * 4;
        float ss[4];
#pragma unroll
        for (int q = 0; q < 4; ++q) { ss[q] = 0.f;
#pragma unroll
            for (int j = 0; j < 4; ++j) ss[q] += (v[q][j].x * v[q][j].x + v[q][j].y * v[q][j].y) + (v[q][j].z * v[q][j].z + v[q][j].w * v[q][j].w); }
#pragma unroll
        for (int m = 1; m < 64; m <<= 1) {
#pragma unroll
            for (int q = 0; q < 4; ++q) ss[q] += __shfl_xor(ss[q], m);
        }
#pragma unroll
        for (int q = 0; q < 4; ++q) {
            const float rstd = rsqrtf(ss[q] * (1.0f / D) + EPS);
#pragma unroll
            for (int j = 0; j < 4; ++j) {
                const int c4 = lane + 64 * j;
                const float4 gg = ((const float4*)g)[c4], s4 = ((const float4*)sh)[c4], c4v = ((const float4*)scl)[c4];
                v[q][j].x = v[q][j].x * rstd * gg.x * (1.f + c4v.x) + s4.x; v[q][j].y = v[q][j].y * rstd * gg.y * (1.f + c4v.y) + s4.y;
                v[q][j].z = v[q][j].z * rstd * gg.z * (1.f + c4v.z) + s4.z; v[q][j].w = v[q][j].w * rstd * gg.w * (1.f + c4v.w) + s4.w;
                uint2 o; o.x = pk2(v[q][j].x, v[q][j].y); o.y = pk2(v[q][j].z, v[q][j].w);
                ((uint2*)(U2T + (size_t)(tok0 + q) * D))[c4] = o;
            }
        }
        float a[64];
        {
            typedef float f32x2 __attribute__((ext_vector_type(2)));
            f32x2 p01[4][4], p23[4][4];
#pragma unroll
            for (int j = 0; j < 4; ++j) {
                p01[j][0] = (f32x2){v[0][j].x, v[1][j].x}; p01[j][1] = (f32x2){v[0][j].y, v[1][j].y}; p01[j][2] = (f32x2){v[0][j].z, v[1][j].z}; p01[j][3] = (f32x2){v[0][j].w, v[1][j].w};
                p23[j][0] = (f32x2){v[2][j].x, v[3][j].x}; p23[j][1] = (f32x2){v[2][j].y, v[3][j].y}; p23[j][2] = (f32x2){v[2][j].z, v[3][j].z}; p23[j][3] = (f32x2){v[2][j].w, v[3][j].w};
            }
#pragma unroll
            for (int e = 0; e < 16; ++e) {
                f32x2 a01 = (f32x2){0.f, 0.f}, a23 = (f32x2){0.f, 0.f};
#pragma unroll
                for (int j = 0; j < 4; ++j) {
                    const float4 wv = *(const float4*)(wrT + e * WRT_LD + 4 * (lane + 64 * j));
                    a01 = p01[j][0] * wv.x + a01; a01 = p01[j][1] * wv.y + a01; a01 = p01[j][2] * wv.z + a01; a01 = p01[j][3] * wv.w + a01;
                    a23 = p23[j][0] * wv.x + a23; a23 = p23[j][1] * wv.y + a23; a23 = p23[j][2] * wv.z + a23; a23 = p23[j][3] * wv.w + a23;
                }
                a[e] = a01[0]; a[16 + e] = a01[1]; a[32 + e] = a23[0]; a[48 + e] = a23[1];
            }
        }
#define RS_STEP(N, M) { const bool hi_ = (lane & (M)) != 0; _Pragma("unroll") for (int k_ = 0; k_ < (N); ++k_) { \
            const float mine_ = hi_ ? a[(N) + k_] : a[k_], oth_ = hi_ ? a[k_] : a[(N) + k_]; a[k_] = mine_ + __shfl_xor(oth_, (M)); } }
        RS_STEP(32, 32) RS_STEP(16, 16) RS_STEP(8, 8) RS_STEP(4, 4) RS_STEP(2, 2) RS_STEP(1, 1)
#undef RS_STEP
        const float sgm = sigmoidf_(a[0]);
        sx[(w * 2 + 0) * 64 + lane] = sgm; sx[(w * 2 + 1) * 64 + lane] = sgm + brt;
        if (bt == 0) {
#pragma unroll
            for (int q = 0; q < 4; ++q)
#pragma unroll
                for (int j = 0; j < 4; ++j) v[q][j] = ((const float4*)(p->out + (size_t)(tokw + 4 + q) * D))[lane + 64 * j];
        }
        asm volatile("s_waitcnt lgkmcnt(0)" ::: "memory");
        if (lane < 4) {
            const float* sgp = sx + (w * 2 + 0) * 64 + lane * 16; const float* sbp = sx + (w * 2 + 1) * 64 + lane * 16;
            float sb[16], sg[16];
#pragma unroll
            for (int e = 0; e < 16; ++e) { sg[e] = sgp[e]; sb[e] = sbp[e]; }
            float gs[4];
#pragma unroll
            for (int gI = 0; gI < 4; ++gI) {
                const float a_ = sb[4 * gI], b_ = sb[4 * gI + 1], c_ = sb[4 * gI + 2], d_ = sb[4 * gI + 3];
                gs[gI] = fmaxf(fmaxf(fmaxf(a_ + b_, a_ + c_), fmaxf(a_ + d_, b_ + c_)), fmaxf(b_ + d_, c_ + d_));
            }
            int grp = 0; float gbest = gs[0];
#pragma unroll
            for (int gI = 1; gI < 4; ++gI) if (gs[gI] > gbest) { gbest = gs[gI]; grp = gI; }
            float b4[4], s4v[4];
#pragma unroll
            for (int k = 0; k < 4; ++k) {
                b4[k] = grp == 0 ? sb[k] : grp == 1 ? sb[4 + k] : grp == 2 ? sb[8 + k] : sb[12 + k];
                s4v[k] = grp == 0 ? sg[k] : grp == 1 ? sg[4 + k] : grp == 2 ? sg[8 + k] : sg[12 + k];
            }
            int i1 = 0; float v1 = b4[0];
#pragma unroll
            for (int k = 1; k < 4; ++k) if (b4[k] > v1) { v1 = b4[k]; i1 = k; }
            int i2 = -1; float v2 = -1e30f;
#pragma unroll
            for (int k = 0; k < 4; ++k) if (k != i1 && b4[k] > v2) { v2 = b4[k]; i2 = k; }
            const int ea = min(i1, i2), eb = max(i1, i2);
            const float sa = ea == 0 ? s4v[0] : ea == 1 ? s4v[1] : s4v[2];
            const float sbv = eb == 1 ? s4v[1] : eb == 2 ? s4v[2] : s4v[3];
            const float inv = 1.0f / (sa + sbv);
            const int pidx = ea == 0 ? (eb - 1) : ea == 1 ? (eb + 1) : 5;
            const int cls = grp * 6 + pidx;
            tokinfo[tok0 + lane] = make_float4(__int_as_float(cls), sa * inv, sbv * inv, 0.f);
            atomicAdd(&bc[cls], 1);
        }
    }
    __syncthreads();
    if (t < 32) ((int*)(p->ws + WS_BLKCNT))[layer * 8192 + blockIdx.x * 32 + t] = (t < 24) ? bc[t] : 0;
}
__device__ __forceinline__ void phase_route2(PP p, unsigned char* smem, int layer) {
    const int t = tid_opaque(), lane = t & 63, w = t >> 6;
    int* tb = (int*)(smem + MOE_TAB_OFF); int* tot = tb + 32;
    int* baseS = (int*)smem; int* clsS = baseS + 32; int* rankS = clsS + 64;
    const int* blkcnt = (const int*)(p->ws + WS_BLKCNT) + layer * 8192;
    const float4* tokinfo = (const float4*)(p->ws + WS_TOKINFO);
    const bf16_t* U2T = (const bf16_t*)(p->ws + WS_U);
    g8::u32x4 rw0[8], rw1[8];
#pragma unroll
    for (int i = 0; i < 8; ++i) {
        const g8::u32x4* rp_ = (const g8::u32x4*)(U2T + (size_t)(blockIdx.x * CHUNK_TOK + w * 8 + i) * D);
        rw0[i] = rp_[lane]; rw1[i] = rp_[64 + lane];
    }
    __syncthreads();
    {
        int* partB = rankS + 64; int* partT = partB + 512;
        const int c = t & 31, part = t >> 5;
        int base = 0, total = 0;
#pragma unroll
        for (int i = 0; i < 16; ++i) { const int b = part * 16 + i; const int v = blkcnt[b * 32 + c]; base += (b < (int)blockIdx.x) ? v : 0; total += v; }
        partB[part * 32 + c] = base; partT[part * 32 + c] = total;
        const int myc = __float_as_int(tokinfo[blockIdx.x * CHUNK_TOK + (t & 63)].x);
        __syncthreads();
        if (t < 24) {
            int bs = 0, ts = 0;
#pragma unroll
            for (int q = 0; q < 16; ++q) { bs += partB[q * 32 + t]; ts += partT[q * 32 + t]; }
            baseS[t] = bs; tot[t] = ts;
        }
        if (t >= 64 && t < 64 + CHUNK_TOK) clsS[t - 64] = myc;
    }
    __syncthreads();
    if (t == 0) {
        int* tinfo = tb + 64; int acc = 0;
        for (int c = 0; c < 24; ++c) {
            tb[c] = acc; const int n = (tot[c] + 255) >> 8; int ea, eb; class_experts(c, ea, eb);
            for (int k = 0; k < n; ++k) { tinfo[2 * (acc + k)] = ea | (eb << 8); tinfo[2 * (acc + k) + 1] = tot[c] - 256 * k; }
            acc += n;
        }
        tb[24] = acc;
    }
    if (t >= 64 && t < 64 + 24) { const int c = t - 64; int r = 0; for (int i = 0; i < CHUNK_TOK; ++i) if (clsS[i] == c) rankS[i] = r++; }
    __syncthreads();
    bf16_t* U2S = (bf16_t*)(p->ws + WS_U2S); int* list = (int*)(p->ws + WS_LIST); float2* wl = (float2*)(p->ws + WS_WL);
#pragma unroll
    for (int i = 0; i < 8; ++i) {
        const int li = w * 8 + i, tok = blockIdx.x * CHUNK_TOK + li;
        const int cls = clsS[li];
        const int pos = 256 * tb[cls] + baseS[cls] + rankS[li];
        g8::u32x4* dp = (g8::u32x4*)(U2S + (size_t)pos * D);
        dp[lane] = rw0[i]; dp[64 + lane] = rw1[i];
        if (lane == 0) { const float4 ti = tokinfo[tok]; list[pos] = tok; wl[pos] = make_float2(ti.y, ti.z); }
    }
}
struct MoeSched {
    const int* tb;
    unsigned A, W0, W1;
    int nN, G, c, mode;
    __device__ __forceinline__ bool next(int i, g8::Unit& u) const {
        const int MT = __builtin_amdgcn_readfirstlane(tb[24]);
        int pm, pn; if (!g8::tile_of(i, G, c, MT, nN, pm, pn)) return false;
        const int ee = __builtin_amdgcn_readfirstlane(tb[64 + 2 * pm]), nv = __builtin_amdgcn_readfirstlane(tb[64 + 2 * pm + 1]);
        const int ea = ee & 255, eb = ee >> 8;
        u.pm = pm; u.pn = pn; u.x0 = nv;
        u.a0 = A + (unsigned)pm * 256 * D * 2; u.a1 = u.a0 + 128u * D * 2;
        if (mode == 0) {
            const int e = pn < 4 ? ea : eb; const unsigned roff = ((unsigned)e * 512 + 128 * (pn & 3)) * D * 2;
            u.b0 = W0 + roff; u.b1 = W1 + roff; u.bd = 0; u.x1 = pn < 4 ? 0 : 1;
        } else {
            u.b0 = W0 + ((unsigned)ea * 1024 + 256 * pn) * 512 * 2; u.b1 = u.b0 + 128u * 512 * 2;
            u.bd = (eb - ea) * 1024 * 512 * 2 - 8 * 128; u.x1 = 0;
        }
        return true;
    }
};
struct EpiUp {
    static constexpr bool PERM = true;
    bf16_t* HB; const float2* wl;
    __device__ __forceinline__ void operator()(const g8::f32x4 (&acc)[2][2][4][2], const g8::Unit& u, int wr, int wc, int fr, int fq) const {
        const int row0 = u.pm * 256 + wr * 64 + fr, col0 = u.pn * 128 + wc * 32 + 8 * fq;
#pragma unroll
        for (int ai = 0; ai < 2; ++ai)
#pragma unroll
            for (int m = 0; m < 4; ++m) {
                const int row = row0 + ai * 128 + m * 16;
                const float2 ww = wl[row]; const float wsel = u.x1 ? ww.y : ww.x;
                float hv[8];
#pragma unroll
                for (int n = 0; n < 2; ++n)
#pragma unroll
                    for (int j = 0; j < 4; ++j) { const float gt = acc[ai][0][m][n][j], up = acc[ai][1][m][n][j]; hv[4 * n + j] = silu_fast(gt) * up * wsel; }
                g8::u32x4 o; o.x = g8::cvt_pk_bf16(hv[0], hv[1]); o.y = g8::cvt_pk_bf16(hv[2], hv[3]); o.z = g8::cvt_pk_bf16(hv[4], hv[5]); o.w = g8::cvt_pk_bf16(hv[6], hv[7]);
                *(g8::u32x4*)(HB + (size_t)row * D + col0) = o;
                asm volatile("" ::: "memory");
            }
    }
};
__device__ __forceinline__ void phase_moe_up(PP p, unsigned char* smem, int layer) {
    MoeSched S; S.tb = (const int*)(smem + MOE_TAB_OFF);
    S.A = (unsigned)WS_U2S; S.W0 = (unsigned)(layer ? WS_WG1 : WS_WG0); S.W1 = (unsigned)(layer ? WS_WU1 : WS_WU0);
    S.nN = 8; S.G = gridDim.x; S.c = blockIdx.x; S.mode = 0;
    EpiUp E; E.HB = (bf16_t*)(p->ws + WS_HBUF); E.wl = (const float2*)(p->ws + WS_WL);
    g8::gemm_phase((LAS unsigned char*)smem, (const char*)p->ws, D, D, D, 1 << 30, S, E);
    {
        const int G = gridDim.x, nun = __builtin_amdgcn_readfirstlane(S.tb[24]) * 8, rem = nun % G;
        convert_experts_on_idle(p, smem, layer, rem, 2, 3);
    }
}
struct EpiDown {
    static constexpr bool PERM = true;
    const int* list; const float* g2; float* out;
    __device__ __forceinline__ void operator()(const g8::f32x4 (&acc)[2][2][4][2], const g8::Unit& u, int wr, int wc, int fr, int fq) const {
        const int r0 = wr * 64 + fr, col0 = u.pn * 256 + wc * 32 + 8 * fq;
#pragma unroll
        for (int ai = 0; ai < 2; ++ai)
#pragma unroll
            for (int m = 0; m < 4; ++m) {
                const int r = r0 + ai * 128 + m * 16;
                if (r < u.x0) {
                    const int tok = list[u.pm * 256 + r];
                    float* orow = out + (size_t)tok * D + col0;
#pragma unroll
                    for (int bj = 0; bj < 2; ++bj)
#pragma unroll
                        for (int n = 0; n < 2; ++n) { g8::f32x4* op = (g8::f32x4*)(orow + bj * 128 + n * 4); const g8::f32x4 hv = *op; const g8::f32x4 gvv = *(const g8::f32x4*)(g2 + col0 + bj * 128 + n * 4); *op = hv + gvv * acc[ai][bj][m][n]; }
                }
                asm volatile("" ::: "memory");
            }
    }
};
__device__ __forceinline__ void phase_moe_down(PP p, unsigned char* smem, int layer) {
    MoeSched S; S.tb = (const int*)(smem + MOE_TAB_OFF);
    S.A = (unsigned)WS_HBUF; S.W0 = (unsigned)(layer ? WS_WD1 : WS_WD0); S.W1 = 0u;
    S.nN = 4; S.G = gridDim.x; S.c = blockIdx.x; S.mode = 1;
    EpiDown E; E.list = (const int*)(p->ws + WS_LIST); E.g2 = (const float*)(p->ws + WS_MOD) + (layer ? 2 * 6144 : 0) + 5 * 1024; E.out = p->out;
    g8::gemm_phase((LAS unsigned char*)smem, (const char*)p->ws, D, D, 512, 8, S, E);
    if (layer == 0) {
        const int G = gridDim.x, nun = __builtin_amdgcn_readfirstlane(S.tb[24]) * 4, rem = nun % G;
        convert_experts_on_idle(p, smem, 1, rem, 0, 2);
    }
}

__device__ __forceinline__ void phase_poolA(PP p) {
    const bf16_t* U = (const bf16_t*)(p->ws + WS_U); bf16_t* PA = (bf16_t*)(p->ws + WS_HL);
    const int t_ = tid_opaque();
    for (int e = blockIdx.x * NTHREADS + t_; e < SEQ * 128; e += gridDim.x * NTHREADS) {
        const int tok = e >> 7, c8 = e & 127, g = c8 >> 5, half = 1 << g;
        const int lo = max(tok - half, 0), hi = min(tok + half, SEQ);
        float s[8];
#pragma unroll
        for (int i = 0; i < 8; ++i) s[i] = 0.f;
        for (int r = lo; r < hi; ++r) {
            const uint4 v = *(const uint4*)(U + (size_t)r * D + 8 * c8);
            s[0] += bflo(v.x); s[1] += bfhi(v.x); s[2] += bflo(v.y); s[3] += bfhi(v.y); s[4] += bflo(v.z); s[5] += bfhi(v.z); s[6] += bflo(v.w); s[7] += bfhi(v.w);
        }
        const float ic = 1.0f / (float)(hi - lo);
        const uint4 me = *(const uint4*)(U + (size_t)tok * D + 8 * c8);
        uint4 o;
        o.x = pk2(s[0] * ic - bflo(me.x), s[1] * ic - bfhi(me.x)); o.y = pk2(s[2] * ic - bflo(me.y), s[3] * ic - bfhi(me.y));
        o.z = pk2(s[4] * ic - bflo(me.z), s[5] * ic - bfhi(me.z)); o.w = pk2(s[6] * ic - bflo(me.w), s[7] * ic - bfhi(me.w));
        *(uint4*)(PA + (size_t)tok * D + 8 * c8) = o;
    }
}

__global__ void __launch_bounds__(NTHREADS, 2) mega(Params pk) {
    extern __shared__ __attribute__((aligned(16))) unsigned char smem[];
    volatile LAS unsigned* st = (volatile LAS unsigned*)(LAS unsigned char*)(smem + LDS_BYTES - 16);
    PP p0 = params_here();
    const int lo = p0->ph_lo, hi = p0->ph_hi;
    XcdBarrier bar; bar.bar = (unsigned*)(p0->ws + WS_CTL); bar.x = 0; bar.st = st;
    if (hi - lo > 1) {
        if (threadIdx.x < 4) st[threadIdx.x] = 0u;
        __syncthreads();
        bar = xcd_barrier_post((unsigned*)(p0->ws + WS_CTL), st);
    }
#define IN(k) (lo <= (k) && (k) < hi)
#define SEAM(k) do { if (IN(k) && IN((k) + 1)) xcd_barrier(bar); } while (0)
#define RUN(k, call) do { if (IN(k)) { const int nr_ = (REPEAT_PH == (k)) ? REPEAT_N + 1 : 1; for (int r_ = 0; r_ < nr_; ++r_) { if (r_) xcd_barrier(bar); call; } } } while (0)
    RUN(0, phase_prep(params_here(), smem));
    SEAM(0);
    RUN(1, phase_norm0(params_here()));
    SEAM(1);
    RUN(2, phase_inproj(params_here(), smem));
    SEAM(2);
    RUN(3, phase_mix3(params_here(), smem));
    SEAM(3);
    RUN(4, phase_hgrnB(params_here()));
    SEAM(4);
    RUN(5, phase_hgrnC(params_here(), smem));
    SEAM(5);
    RUN(6, phase_outproj(params_here(), smem));
    SEAM(6);
    for (int layer = 0; layer < 2; ++layer) {
        if (layer == 1) {
            RUN(12, phase_normpool(params_here(), smem));
            SEAM(12);
            RUN(13, phase_poolgemm(params_here(), smem));
            SEAM(13);
        }
        const int pb = layer ? 14 : 7;
        RUN(pb, phase_route1(params_here(), smem, layer));
        SEAM(pb);
        RUN(pb + 1, phase_route2(params_here(), smem, layer));
        SEAM(pb + 1);
        RUN(pb + 2, phase_moe_up(params_here(), smem, layer));
        SEAM(pb + 2);
        RUN(pb + 3, phase_moe_down(params_here(), smem, layer));
        if (IN(pb + 3) && hi > pb + 4) xcd_barrier(bar);
    }
    RUN(18, phase_final(params_here()));
#undef IN
#undef SEAM
#undef RUN
}

extern "C" void kernel_launch(void* const* d_in, const int* in_sizes, int n_in, void* d_out, int out_size, void* d_ws, size_t ws_size, hipStream_t stream) {
    static int grid = 0;
    if (grid == 0) {
        if (n_in != 21 || in_sizes[0] != SEQ * D || out_size != SEQ * D || ws_size < WS_END) {
            fprintf(stderr, "kernel_launch: unexpected shapes (n_in %d, in0 %d, out %d, ws %zu < %zu); nothing launched\n", n_in, n_in > 0 ? in_sizes[0] : -1, out_size, ws_size, (size_t)WS_END);
            grid = -1; return;
        }
        int dev = 0, cus = 0, per_cu = 0;
        if (hipGetDevice(&dev) != hipSuccess || hipDeviceGetAttribute(&cus, hipDeviceAttributeMultiprocessorCount, dev) != hipSuccess) { grid = -1; return; }
        if (hipFuncSetAttribute((const void*)mega, hipFuncAttributeMaxDynamicSharedMemorySize, LDS_BYTES) != hipSuccess) { fprintf(stderr, "kernel_launch: hipFuncSetAttribute failed\n"); grid = -1; return; }
        if (hipOccupancyMaxActiveBlocksPerMultiprocessor(&per_cu, (const void*)mega, NTHREADS, LDS_BYTES) != hipSuccess || per_cu < 1) {
            fprintf(stderr, "kernel_launch: occupancy query reports %d blocks per CU\n", per_cu); per_cu = 1;
        }
        (void)hipGetLastError();
        grid = cus;
    }
    if (grid < 0) return;
    (void)hipMemsetAsync((char*)d_ws + WS_CTL, 0, CTL_BYTES, stream);
    Params p{};
    const float** pp = (const float**)&p;
    for (int i = 0; i < 21; ++i) pp[i] = (const float*)d_in[i];
    p.out = (float*)d_out; p.ws = (unsigned char*)d_ws;
#if N_LAUNCH_MODE == 1
    p.ph_lo = 0; p.ph_hi = NPH;
    void* args[] = {&p};
    hipError_t e = hipLaunchCooperativeKernel((const void*)mega, dim3(grid), dim3(NTHREADS), args, LDS_BYTES, stream);
    if (e != hipSuccess) fprintf(stderr, "kernel_launch: cooperative launch failed: %s (grid %d)\n", hipGetErrorString(e), grid);
#else
    for (int ph = 0; ph < NPH; ++ph) {
        p.ph_lo = ph; p.ph_hi = ph + 1;
        hipLaunchKernelGGL(mega, dim3(grid), dim3(NTHREADS), LDS_BYTES, stream, p);
    }
#endif
}
```
